# Optimizing an MI355X kernel written in HIP

```python
import jax, jax.numpy as jnp
from jax import lax
import numpy as np

D_MODEL = 1024
BATCH = 4
SEQ = 8192
DEPTH = 2

N_MIXERS = 2
ATTN_GROUPS = ((128, 1), (512, 4), (2048, 16))
N_ATTN_GROUPS = len(ATTN_GROUPS)
HEADS_PER_GROUP = 16
HEAD_DIM = D_MODEL // HEADS_PER_GROUP
ATTN_WIDTH = HEADS_PER_GROUP * HEAD_DIM
ATTN_QKV_COLS = N_ATTN_GROUPS * 3 * ATTN_WIDTH
SGU_CHUNK = 128
SGU_WIDTH = 2 * D_MODEL
SGU_GROUP_CH = 128
SGU_GROUPS = SGU_WIDTH // SGU_GROUP_CH
DEEPNORM_ALPHA = (2 * DEPTH) ** 0.25
DEEPNORM_BETA = (8 * DEPTH) ** -0.25
LN_EPS = 1e-5
NEG_INF = -1e30
N_A_LAYERS = (DEPTH + 1) // 2
N_B_LAYERS = DEPTH // 2

kernel_name = "hybrid_dilated_swa_sgu_encoder"


def layer_norm(x, g, b):
    xf = x.astype(jnp.float32)
    mu = jnp.mean(xf, axis=-1, keepdims=True)
    var = jnp.mean(jnp.square(xf - mu), axis=-1, keepdims=True)
    return ((xf - mu) * lax.rsqrt(var + LN_EPS) * g.astype(jnp.float32)
            + b.astype(jnp.float32)).astype(x.dtype)


def alibi_slopes(n):
    return 2.0 ** (-8.0 * jnp.arange(1, n + 1, dtype=jnp.float32) / n)


def dilated_window_attention(q, k, v, slopes, window, dilation):
    B, S, H, Dh = q.shape
    d = dilation
    L = S // d
    w = window // (2 * d)
    nb = -(-L // w)
    Lp = nb * w

    def strided(a):
        return a.reshape(B, L, d, H, Dh).transpose(0, 2, 3, 1, 4)

    qb = jnp.pad(strided(q), ((0, 0),) * 3 + ((0, Lp - L), (0, 0))).reshape(B, d, H, nb, w, Dh)
    pad_kv = ((0, 0),) * 3 + ((w, Lp - L + w), (0, 0))

    def band(a):
        ab = jnp.pad(strided(a), pad_kv).reshape(B, d, H, nb + 2, w, Dh)
        return jnp.concatenate([ab[:, :, :, :-2], ab[:, :, :, 1:-1], ab[:, :, :, 2:]], axis=4)

    kb, vb = band(k), band(v)
    rel = (jnp.arange(3 * w)[None, :] - w) - jnp.arange(w)[:, None]
    key_idx = jnp.arange(nb)[:, None] * w - w + jnp.arange(3 * w)[None, :]
    valid = (jnp.abs(rel) <= w)[None] & ((key_idx >= 0) & (key_idx < L))[:, None, :]
    dist = (d * jnp.abs(rel)).astype(jnp.float32)

    s = jnp.einsum('bzhnqd,bzhnkd->bzhnqk', qb, kb).astype(jnp.float32) * (Dh ** -0.5)
    s = s - slopes[:, None, None, None] * dist
    s = jnp.where(valid, s, NEG_INF)
    m = jnp.max(s, axis=-1, keepdims=True)
    p = jnp.exp(s - m)
    den = jnp.sum(p, axis=-1, keepdims=True)
    o = jnp.einsum('bzhnqk,bzhnkd->bzhnqd', p, vb.astype(jnp.float32)) / den
    lse = (m + jnp.log(den))[..., 0]

    o = o.reshape(B, d, H, Lp, Dh)[:, :, :, :L].transpose(0, 3, 1, 2, 4).reshape(B, S, H, Dh)
    lse = lse.reshape(B, d, H, Lp)[:, :, :, :L].transpose(0, 3, 1, 2).reshape(B, S, H)
    return o, lse


def mixer_dilated_attention(h, w_in, w_out, slopes):
    B, S, _ = h.shape
    z = h @ w_in
    qkv = z[..., :ATTN_QKV_COLS].reshape(B, S, N_ATTN_GROUPS, 3, HEADS_PER_GROUP, HEAD_DIM)
    gate = z[..., ATTN_QKV_COLS:]
    outs, lses = [], []
    for g, (window, dil) in enumerate(ATTN_GROUPS):
        o, l = dilated_window_attention(qkv[:, :, g, 0], qkv[:, :, g, 1], qkv[:, :, g, 2],
                                        slopes[g], window, dil)
        outs.append(o)
        lses.append(l)
    wts = jax.nn.softmax(jnp.stack(lses, axis=0), axis=0)
    o = jnp.sum(wts[..., None] * jnp.stack(outs, axis=0), axis=0)
    y = o.reshape(B, S, ATTN_WIDTH).astype(h.dtype) * jax.nn.silu(gate)
    return y @ w_out


def mixer_spatial_gating(h, w_in, ln_g, ln_b, w_s, b_s, w_out):
    B, S, _ = h.shape
    E = SGU_WIDTH
    z = h @ w_in
    uv = jax.nn.gelu(z[..., :2 * E], approximate=False)
    gate = z[..., 2 * E:]
    u, v = uv[..., :E], uv[..., E:]
    v = layer_norm(v, ln_g, ln_b)
    vc = v.reshape(B, S // SGU_CHUNK, SGU_CHUNK, SGU_GROUPS, SGU_GROUP_CH)
    sv = jnp.einsum('gts,bnsgc->bntgc', w_s, vc) + b_s.T[None, None, :, :, None]
    y = u * sv.reshape(B, S, E) * jax.nn.silu(gate)
    return y @ w_out


def setup_inputs(seed: int = 0) -> dict:
    key = jax.random.key(seed)
    ks = jax.random.split(key, 16)
    D, E, AW = D_MODEL, SGU_WIDTH, ATTN_WIDTH
    nrm = jax.random.normal
    f32 = jnp.float32
    return {
        "x": nrm(ks[0], (BATCH, SEQ, D), f32),
        "c": nrm(ks[1], (BATCH, D), f32),
        "ada_w": nrm(ks[2], (DEPTH, D, 3 * D), f32) * (0.5 * D ** -0.5),
        "ada_b": nrm(ks[3], (DEPTH, 3 * D), f32) * 0.02,
        "post_ln_g": 1.0 + 0.05 * nrm(ks[4], (DEPTH, D), f32),
        "post_ln_b": 0.02 * nrm(ks[5], (DEPTH, D), f32),
        "a_w_in": nrm(ks[6], (N_A_LAYERS, D, ATTN_QKV_COLS + AW), f32) * D ** -0.5,
        "a_w_out": nrm(ks[7], (N_A_LAYERS, AW, D), f32) * (AW ** -0.5 * DEEPNORM_BETA),
        "b_w_in": nrm(ks[8], (N_B_LAYERS, D, 3 * E), f32) * D ** -0.5,
        "b_ln_g": 1.0 + 0.05 * nrm(ks[9], (N_B_LAYERS, E), f32),
        "b_ln_b": 0.02 * nrm(ks[10], (N_B_LAYERS, E), f32),
        "b_w_s": nrm(ks[11], (N_B_LAYERS, SGU_GROUPS, SGU_CHUNK, SGU_CHUNK), f32) * SGU_CHUNK ** -0.5,
        "b_b_s": 1.0 + 0.1 * nrm(ks[12], (N_B_LAYERS, SGU_GROUPS, SGU_CHUNK), f32),
        "b_w_out": nrm(ks[13], (N_B_LAYERS, E, D), f32) * (E ** -0.5 * DEEPNORM_BETA),
    }


def reference(x, c, ada_w, ada_b, post_ln_g, post_ln_b, a_w_in, a_w_out,
              b_w_in, b_ln_g, b_ln_b, b_w_s, b_b_s, b_w_out):
    slopes = alibi_slopes(N_ATTN_GROUPS * HEADS_PER_GROUP).reshape(N_ATTN_GROUPS, HEADS_PER_GROUP)
    cond = jax.nn.silu(c)
    for i in range(DEPTH):
        mod = cond @ ada_w[i] + ada_b[i]
        shift, scale, gate = jnp.split(mod, 3, axis=-1)
        h = x * (1.0 + scale[:, None, :]) + shift[:, None, :]
        j = i // N_MIXERS
        if i % N_MIXERS == 0:
            y = mixer_dilated_attention(h, a_w_in[j], a_w_out[j], slopes)
        else:
            y = mixer_spatial_gating(h, b_w_in[j], b_ln_g[j], b_ln_b[j], b_w_s[j], b_b_s[j], b_w_out[j])
        x = layer_norm(DEEPNORM_ALPHA * x + gate[:, None, :] * y, post_ln_g[i], post_ln_b[i])
    return x
```

```cpp
#include <hip/hip_runtime.h>
#include <hip/hip_cooperative_groups.h>
#include <cstdio>
#include <cstdint>
namespace cg = cooperative_groups;

#ifndef MK_MULTI
#define MK_MULTI 0
#endif

#define LAS __attribute__((address_space(3)))
typedef unsigned short bf16_t;
typedef short bf16x8 __attribute__((ext_vector_type(8)));
typedef float f32x4 __attribute__((ext_vector_type(4)));
typedef float f32x2 __attribute__((ext_vector_type(2)));
typedef float f32x16 __attribute__((ext_vector_type(16)));
typedef unsigned u32x4 __attribute__((ext_vector_type(4)));
typedef unsigned u32x2 __attribute__((ext_vector_type(2)));
typedef __bf16 bf16x2_t __attribute__((ext_vector_type(2)));

constexpr int SEQ = 8192, DM = 1024, MTOK = 4 * SEQ;
constexpr int HALF_TOK = 16384;
constexpr int NQK = 7168;
constexpr int NZ1 = 4096;
constexpr float ALPHA = 1.41421356237309515f;
constexpr float LN_EPS = 1e-5f;
constexpr float LOG2E = 1.4426950408889634f;
constexpr float C2 = 0.125f * LOG2E;
constexpr int NPHASE = 12;

constexpr size_t MiB = 1u << 20;
constexpr size_t WS_MOD = 1 * MiB;
constexpr size_t WS_WAIN = 2 * MiB;
constexpr size_t WS_WAOUT = 22 * MiB;
constexpr size_t WS_WBIN = 24 * MiB;
constexpr size_t WS_WBOUT = 36 * MiB;
constexpr size_t WS_WS = 40 * MiB;
constexpr size_t WS_STV = 44 * MiB;
constexpr size_t WS_HB = 48 * MiB;
constexpr size_t WS_Z = 112 * MiB;
constexpr size_t WS_VT = WS_Z + 224 * MiB;
constexpr size_t WS_VT1 = WS_Z + 256 * MiB;
constexpr size_t WS_END = 496 * MiB;

constexpr int LDS_BYTES = 155648;

__device__ __forceinline__ unsigned pk2(float lo, float hi) { f32x2 v = {lo, hi}; bf16x2_t b = __builtin_convertvector(v, bf16x2_t); return __builtin_bit_cast(unsigned, b); }
__device__ __forceinline__ float bflo(unsigned u) { return __builtin_bit_cast(float, u << 16); }
__device__ __forceinline__ float bfhi(unsigned u) { return __builtin_bit_cast(float, u & 0xffff0000u); }
__device__ __forceinline__ float fexp2(float x) { return __builtin_amdgcn_exp2f(x); }
__device__ __forceinline__ float flog2(float x) { return __builtin_amdgcn_logf(x); }
__device__ __forceinline__ float frcp(float x) { return __builtin_amdgcn_rcpf(x); }
__device__ __forceinline__ float silu_f(float x) { return x * frcp(1.0f + fexp2(-x * LOG2E)); }
__device__ __forceinline__ f32x4 silu4(f32x4 v) { return (f32x4){silu_f(v[0]), silu_f(v[1]), silu_f(v[2]), silu_f(v[3])}; }
__device__ __forceinline__ float wave_sum(float v) {
#pragma unroll
    for (int o = 1; o < 64; o <<= 1) v += __shfl_xor(v, o);
    return v;
}
__device__ __forceinline__ f32x2 gelu_pk(f32x2 v) {
    const f32x2 av = __builtin_elementwise_abs(v), d = av * 0.2316418882f + 1.0f;
    f32x2 t; t.x = frcp(d.x); t.y = frcp(d.y);
    f32x2 q = t * 0.5307027145f + (-0.7265760135f); q = q * t + 0.7107068705f; q = q * t + (-0.142248368f); q = q * t + 0.127414796f; q = q * t;
    const f32x2 s = (v * v) * (-0.72134752044f);
    f32x2 e; e.x = fexp2(s.x); e.y = fexp2(s.y);
    const f32x2 m = v * (q * e), r = v - m;
    f32x2 o; o.x = v.x < 0.f ? m.x : r.x; o.y = v.y < 0.f ? m.y : r.y; return o;
}
__device__ __forceinline__ f32x4 gelu4(f32x4 v) { f32x2 a = gelu_pk((f32x2){v[0], v[1]}), b = gelu_pk((f32x2){v[2], v[3]}); return (f32x4){a.x, a.y, b.x, b.y}; }

struct Args { const float* in[14]; float* out; unsigned char* ws; int ph_lo, ph_hi; };

namespace pg8 {
constexpr int BM = 256, BK = 64, HALF = 128, HTB = HALF * BK * 2, STAGE_BYTES = 8 * HTB;
__device__ __forceinline__ int lds_byte(int r, int c) { const int st = (r >> 4) * 2 + (c >> 5), rr = r & 15, cc = c & 31, ob = rr * 64 + cc * 2; return st * 1024 + (ob ^ (((ob >> 9) & 1) << 5)); }
__device__ __forceinline__ void stage_rc(int b, int& R, int& C) { const int st = b / 1024, sb = b % 1024, swz = sb ^ (((sb >> 9) & 1) << 5); R = (st >> 1) * 16 + swz / 64; C = (st & 1) * 32 + (swz % 64) / 2; }
__device__ __forceinline__ int perm32(int rho) { const int n = rho >> 4, i = rho & 15; return 8 * (i >> 2) + 4 * n + (i & 3); }

struct Unit { const char* A; const char* B; unsigned ldb; int kind, pm, pn, g; };

__device__ __forceinline__ void static_tile(int L, int nM, int nN, int& pm, int& pn) {
    const int nwg = nM * nN; int wgid = L;
    { const int q = nwg / 8, r = nwg % 8, xcd = wgid % 8, off = wgid / 8; wgid = (xcd < r ? xcd * (q + 1) : r * (q + 1) + (xcd - r) * q) + off; }
    const int nig = 8 * nN, gid = wgid / nig, fm = gid * 8, gsz = (nM - fm) < 8 ? (nM - fm) : 8;
    pm = fm + ((wgid % nig) % gsz); pn = (wgid % nig) / gsz;
}

template <class Epi, class Sched>
__device__ __forceinline__ void gemm_phase(LAS unsigned char* lds, const unsigned lda, const int K, const Sched& S, const Epi& E) {
    const int tid = threadIdx.x, wid = __builtin_amdgcn_readfirstlane(tid >> 6), lane = tid & 63, wr = wid >> 2, wc = wid & 3, fr = lane & 15, fq = lane >> 4;
    const int nt = K / BK;
    unsigned voffA[2], rbB[2], c2B[2];
#pragma unroll
    for (int i = 0; i < 2; ++i) { int R, C; stage_rc(tid * 16 + i * 8192, R, C); const int Rb = Epi::PERM ? ((R & ~31) + perm32(R & 31)) : R;
        voffA[i] = (unsigned)R * lda + (unsigned)C * 2u; rbB[i] = (unsigned)Rb; c2B[i] = (unsigned)C * 2u; }
    const size_t kstep = (size_t)(BK * 2);
    const size_t hstepA = (size_t)HALF * lda;
    const unsigned ldsw = (unsigned)wid * 1024u;
    const int aoff = lds_byte(wr * 64 + fr, fq * 8), boff = lds_byte(wc * 32 + fr, fq * 8);
#define PG8_SA(b, h) (((b) * 2 + (h)) * HTB)
#define PG8_SB(b, h) ((4 + (b) * 2 + (h)) * HTB)
#define PG8_STAGE(bufoff, gbase, voff) do { _Pragma("unroll") for (int _i = 0; _i < 2; ++_i) \
        __builtin_amdgcn_global_load_lds((const unsigned*)((const char*)(gbase) + (voff)[_i]), (LAS unsigned*)(lds + (bufoff) + ldsw + _i * 8192), 16, 0, 0); } while (0)
#define PG8_STAGEB(bufoff, gbase, ldbv) do { _Pragma("unroll") for (int _i = 0; _i < 2; ++_i) \
        __builtin_amdgcn_global_load_lds((const unsigned*)((const char*)(gbase) + (rbB[_i] * (ldbv) + c2B[_i])), (LAS unsigned*)(lds + (bufoff) + ldsw + _i * 8192), 16, 0, 0); } while (0)
#define PG8_LDA(dst, b, h) do { _Pragma("unroll") for (int m = 0; m < 4; ++m) _Pragma("unroll") for (int k = 0; k < 2; ++k) dst[m][k] = *(const LAS bf16x8*)(lds + PG8_SA(b, h) + aoff + m * 2048 + k * 1024); } while (0)
#define PG8_LDB(dst, b, h) do { _Pragma("unroll") for (int n = 0; n < 2; ++n) _Pragma("unroll") for (int k = 0; k < 2; ++k) dst[n][k] = *(const LAS bf16x8*)(lds + PG8_SB(b, h) + boff + n * 2048 + k * 1024); } while (0)
#define PG8_MMA(ai, bj, At, Bt) do { __builtin_amdgcn_s_setprio(1); _Pragma("unroll") for (int m = 0; m < 4; ++m) _Pragma("unroll") for (int n = 0; n < 2; ++n) _Pragma("unroll") for (int k = 0; k < 2; ++k) \
        acc[ai][bj][m][n] = __builtin_amdgcn_mfma_f32_16x16x32_bf16(Bt[n][k], At[m][k], acc[ai][bj][m][n], 0, 0, 0); __builtin_amdgcn_s_setprio(0); } while (0)
#define PG8_WAIT_V(n) asm volatile("s_waitcnt vmcnt(" #n ")" ::: "memory")
#define PG8_WAIT_L(n) asm volatile("s_waitcnt lgkmcnt(" #n ")" ::: "memory")
#define PG8_BAR __builtin_amdgcn_s_barrier()
#define PG8_SCHED __builtin_amdgcn_sched_barrier(0)
    Unit cur, nxt; int ui = 0;
    if (!S.next(0, cur)) return;
    f32x4 acc[2][2][4][2];
#pragma unroll
    for (int a = 0; a < 2; ++a)
#pragma unroll
        for (int b = 0; b < 2; ++b)
#pragma unroll
            for (int m = 0; m < 4; ++m)
#pragma unroll
                for (int n = 0; n < 2; ++n) acc[a][b][m][n] = (f32x4){0.f, 0.f, 0.f, 0.f};
    bf16x8 At[4][2], B0[2][2], B1[2][2];
    const char* cA = cur.A; const char* cB = cur.B;
    unsigned ldbc = cur.ldb; size_t hBc = (size_t)HALF * ldbc;
    PG8_STAGEB(PG8_SB(0, 0), cB, ldbc); PG8_STAGEB(PG8_SB(0, 1), cB + hBc, ldbc); PG8_STAGE(PG8_SA(0, 0), cA, voffA); PG8_STAGE(PG8_SA(0, 1), cA + hstepA, voffA);
    if (wr == 1) PG8_BAR;
    PG8_WAIT_V(2); PG8_BAR;
    PG8_STAGEB(PG8_SB(1, 0), cB + kstep, ldbc); PG8_STAGE(PG8_SA(1, 0), cA + kstep, voffA); PG8_STAGEB(PG8_SB(1, 1), cB + hBc + kstep, ldbc);
    PG8_WAIT_V(6); PG8_BAR;
    for (;;) {
        const bool has_next = S.next(ui + 1, nxt);
        const char* nA = has_next ? nxt.A : cA; const char* nB = has_next ? nxt.B : cB;
        const unsigned ldbn = has_next ? nxt.ldb : ldbc; const size_t hBn = (size_t)HALF * ldbn;
        for (int t = 0; t < nt; t += 2) {
            const bool last = (t == nt - 2);
            const char* a1 = cA + (size_t)(t + 1) * kstep;
            const char* a2 = last ? nA : cA + (size_t)(t + 2) * kstep; const char* b2 = last ? nB : cB + (size_t)(t + 2) * kstep;
            const char* a3 = a2 + kstep; const char* b3 = b2 + kstep;
            const unsigned ldb2 = last ? ldbn : ldbc; const size_t hB2 = last ? hBn : hBc;
            PG8_LDB(B0, 0, 0); PG8_LDB(B1, 0, 1); PG8_SCHED; PG8_LDA(At, 0, 0); PG8_STAGE(PG8_SA(1, 1), a1 + hstepA, voffA);
            PG8_WAIT_V(8); PG8_WAIT_L(0); PG8_BAR; PG8_MMA(0, 0, At, B0); PG8_MMA(0, 1, At, B1); PG8_BAR; PG8_SCHED;
            PG8_LDA(At, 0, 1); PG8_STAGEB(PG8_SB(0, 0), b2, ldb2); PG8_STAGEB(PG8_SB(0, 1), b2 + hB2, ldb2); PG8_STAGE(PG8_SA(0, 0), a2, voffA);
            PG8_WAIT_V(8); PG8_WAIT_L(0); PG8_BAR; PG8_MMA(1, 0, At, B0); PG8_MMA(1, 1, At, B1); PG8_BAR; PG8_SCHED;
            PG8_LDB(B0, 1, 0); PG8_LDB(B1, 1, 1); PG8_SCHED; PG8_LDA(At, 1, 0); PG8_STAGE(PG8_SA(0, 1), a2 + hstepA, voffA);
            PG8_WAIT_V(8); PG8_WAIT_L(0); PG8_BAR; PG8_MMA(0, 0, At, B0); PG8_MMA(0, 1, At, B1); PG8_BAR; PG8_SCHED;
            PG8_LDA(At, 1, 1); PG8_STAGEB(PG8_SB(1, 0), b3, ldb2); PG8_STAGEB(PG8_SB(1, 1), b3 + hB2, ldb2); PG8_STAGE(PG8_SA(1, 0), a3, voffA);
            PG8_WAIT_V(8); PG8_WAIT_L(0); PG8_BAR; PG8_MMA(1, 0, At, B0); PG8_MMA(1, 1, At, B1); PG8_BAR; PG8_SCHED;
        }
        if (wr == 0) PG8_BAR;
        E(acc, cur, wr, wc, fr, fq);
        if (!has_next) break;
#pragma unroll
        for (int a = 0; a < 2; ++a)
#pragma unroll
            for (int b = 0; b < 2; ++b)
#pragma unroll
                for (int m = 0; m < 4; ++m)
#pragma unroll
                    for (int n = 0; n < 2; ++n) acc[a][b][m][n] = (f32x4){0.f, 0.f, 0.f, 0.f};
        cur = nxt; cA = nA; cB = nB; ldbc = ldbn; hBc = hBn; ++ui;
        if (wr == 1) PG8_BAR;
    }
    PG8_WAIT_V(0);
    PG8_BAR;
#undef PG8_SA
#undef PG8_SB
#undef PG8_STAGE
#undef PG8_STAGEB
#undef PG8_LDA
#undef PG8_LDB
#undef PG8_MMA
#undef PG8_WAIT_V
#undef PG8_WAIT_L
#undef PG8_BAR
#undef PG8_SCHED
}
}
using pg8::Unit;

struct SchedG1 {
    int G, c; const char* HBh; const char* W;
    __device__ __forceinline__ bool next(int i, Unit& u) const {
        const long Ll = (long)i * G + c; if (Ll >= 2560) return false;
        const int L = (int)Ll;
        if (L < 1792) {
            const int xcd = L & 7, off = L >> 3, pm = xcd * 8 + (off & 7), pn = off >> 3, seg = pn >> 2;
            const int wrow = (seg < 6 ? (seg >> 1) * 3072 + (seg & 1) * 1024 : 9216) + (pn & 3) * 256;
            u.A = HBh + (size_t)pm * 256 * 2048; u.B = W + (size_t)wrow * 2048; u.ldb = 2048u; u.kind = 0; u.pm = pm; u.pn = pn; u.g = 0;
        } else {
            int v = L - 1792; const int g = v >> 8; v &= 255;
            const int xcd = v & 7, off = v >> 3, pm = off >> 3, pn = xcd * 8 + (off & 7);
            const int sh = 2 * g, Lg = SEQ >> sh, bl = pn >> 5, vi = (pn & 31) * 256, r = vi / Lg, j0 = vi % Lg;
            const int tokrow = bl * SEQ + (j0 << sh) + r;
            u.A = W + (size_t)(g * 3072 + 2048 + pm * 256) * 2048; u.B = HBh + (size_t)tokrow * 2048; u.ldb = 2048u << sh; u.kind = 1; u.pm = pm; u.pn = pn; u.g = g;
        }
        return true;
    }
};
struct SchedG3 {
    int G, c; const char* HB; const char* W;
    __device__ __forceinline__ bool next(int i, Unit& u) const {
        const long Ll = (long)i * G + c; if (Ll >= 3072) return false;
        const int L = (int)Ll;
        if (L < 2048) {
            int pm, pn; pg8::static_tile(L, 128, 16, pm, pn);
            const int wrow = pn < 8 ? pn * 256 : 4096 + (pn - 8) * 256;
            u.A = HB + (size_t)pm * 256 * 2048; u.B = W + (size_t)wrow * 2048; u.ldb = 2048u; u.kind = 0; u.pm = pm; u.pn = pn; u.g = 0;
        } else {
            const int v = L - 2048, xcd = v & 7, off = v >> 3, pn = xcd * 16 + (off & 15), pm = off >> 4;
            u.A = W + (size_t)(2048 + pm * 256) * 2048; u.B = HB + (size_t)pn * 256 * 2048; u.ldb = 2048u; u.kind = 1; u.pm = pm; u.pn = pn; u.g = 0;
        }
        return true;
    }
};
struct SchedOut {
    int G, c; const char* A; size_t lda; const char* W; unsigned ldb;
    __device__ __forceinline__ bool next(int i, Unit& u) const {
        const long Ll = (long)i * G + c; if (Ll >= 512) return false;
        int pm, pn; pg8::static_tile((int)Ll, 128, 4, pm, pn);
        u.A = A + (size_t)pm * 256 * lda; u.B = W + (size_t)pn * 256 * ldb; u.ldb = ldb; u.kind = 0; u.pm = pm; u.pn = pn; u.g = 0;
        return true;
    }
};

struct EpiG1 {
    static constexpr bool PERM = true;
    bf16_t* QK; bf16_t* VT;
    __device__ __forceinline__ void operator()(const f32x4 (&acc)[2][2][4][2], const Unit& u, int wr, int wc, int fr, int fq) const {
        bf16_t* base; size_t ldc; int mode = 0;
        if (u.kind == 0) { base = QK; ldc = NQK; const int seg = u.pn >> 2; mode = (seg == 6) ? 2 : ((seg & 1) == 0 ? 1 : 0); }
        else { base = VT + (size_t)u.g * 1024 * HALF_TOK; ldc = HALF_TOK; }
        const int row0 = u.pm * 256 + wr * 64 + fr, col0 = u.pn * 256 + wc * 32 + 8 * fq;
#pragma unroll
        for (int ai = 0; ai < 2; ++ai)
#pragma unroll
            for (int m = 0; m < 4; ++m) { bf16_t* rowp = base + (size_t)(row0 + ai * 128 + m * 16) * ldc + col0;
#pragma unroll
                for (int bj = 0; bj < 2; ++bj) { f32x4 v0 = acc[ai][bj][m][0], v1 = acc[ai][bj][m][1];
                    if (mode == 1) { v0 = v0 * C2; v1 = v1 * C2; }
                    else if (mode == 2) { v0 = silu4(v0); v1 = silu4(v1); }
                    u32x4 w; w.x = pk2(v0[0], v0[1]); w.y = pk2(v0[2], v0[3]); w.z = pk2(v1[0], v1[1]); w.w = pk2(v1[2], v1[3]);
                    *(u32x4*)(rowp + bj * 128) = w; } }
    }
};
struct EpiG3 {
    static constexpr bool PERM = true;
    bf16_t* Z1; bf16_t* VT1; float* STV;
    __device__ __forceinline__ void operator()(const f32x4 (&acc)[2][2][4][2], const Unit& u, int wr, int wc, int fr, int fq) const {
        const int row0 = u.pm * 256 + wr * 64 + fr, col0 = u.pn * 256 + wc * 32 + 8 * fq;
        if (u.kind == 0) {
            const bool isg = u.pn >= 8;
#pragma unroll
            for (int ai = 0; ai < 2; ++ai)
#pragma unroll
                for (int m = 0; m < 4; ++m) { bf16_t* rowp = Z1 + (size_t)(row0 + ai * 128 + m * 16) * NZ1 + col0;
#pragma unroll
                    for (int bj = 0; bj < 2; ++bj) { f32x4 v0 = acc[ai][bj][m][0], v1 = acc[ai][bj][m][1];
                        if (isg) { v0 = silu4(v0); v1 = silu4(v1); } else { v0 = gelu4(v0); v1 = gelu4(v1); }
                        u32x4 w; w.x = pk2(v0[0], v0[1]); w.y = pk2(v0[2], v0[3]); w.z = pk2(v1[0], v1[1]); w.w = pk2(v1[2], v1[3]);
                        *(u32x4*)(rowp + bj * 128) = w; } }
        } else {
#pragma unroll
            for (int bj = 0; bj < 2; ++bj) {
                f32x4 s0 = {0.f, 0.f, 0.f, 0.f}, s1 = s0, q0 = s0, q1 = s0;
#pragma unroll
                for (int ai = 0; ai < 2; ++ai)
#pragma unroll
                    for (int m = 0; m < 4; ++m) { bf16_t* rowp = VT1 + (size_t)(row0 + ai * 128 + m * 16) * MTOK + col0 + bj * 128;
                        const f32x4 v0 = gelu4(acc[ai][bj][m][0]), v1 = gelu4(acc[ai][bj][m][1]);
                        s0 += v0; s1 += v1; q0 += v0 * v0; q1 += v1 * v1;
                        u32x4 w; w.x = pk2(v0[0], v0[1]); w.y = pk2(v0[2], v0[3]); w.z = pk2(v1[0], v1[1]); w.w = pk2(v1[2], v1[3]);
                        *(u32x4*)rowp = w; }
#pragma unroll
                for (int o = 1; o < 16; o <<= 1) {
#pragma unroll
                    for (int e = 0; e < 4; ++e) { s0[e] += __shfl_xor(s0[e], o); s1[e] += __shfl_xor(s1[e], o); q0[e] += __shfl_xor(q0[e], o); q1[e] += __shfl_xor(q1[e], o); } }
                if (fr == 0) { const int tok0 = col0 + bj * 128; float* sp = STV + ((size_t)tok0 * 16 + u.pm * 2 + wr) * 2;
#pragma unroll
                    for (int e = 0; e < 4; ++e) { *(f32x2*)(sp + (size_t)e * 32) = (f32x2){s0[e], q0[e]}; *(f32x2*)(sp + (size_t)(4 + e) * 32) = (f32x2){s1[e], q1[e]}; } }
            }
        }
    }
};
struct EpiRes {
    static constexpr bool PERM = false;
    const float* res; float* dst; const float* gate;
    __device__ __forceinline__ void operator()(const f32x4 (&acc)[2][2][4][2], const Unit& u, int wr, int wc, int fr, int fq) const {
        const int col0 = u.pn * 256 + wc * 32 + 4 * fq; const float* gp = gate + (size_t)(u.pm >> 5) * 3072 + col0;
        f32x4 gv[2][2];
#pragma unroll
        for (int bj = 0; bj < 2; ++bj)
#pragma unroll
            for (int n = 0; n < 2; ++n) gv[bj][n] = *(const f32x4*)(gp + bj * 128 + n * 16);
#pragma unroll
        for (int ai = 0; ai < 2; ++ai)
#pragma unroll
            for (int m = 0; m < 4; ++m) { const size_t off = (size_t)(u.pm * 256 + ai * 128 + wr * 64 + m * 16 + fr) * DM + col0;
#pragma unroll
                for (int bj = 0; bj < 2; ++bj)
#pragma unroll
                    for (int n = 0; n < 2; ++n) { const f32x4 r = *(const f32x4*)(res + off + bj * 128 + n * 16);
                        *(f32x4*)(dst + off + bj * 128 + n * 16) = r * ALPHA + gv[bj][n] * acc[ai][bj][m][n]; }
                asm volatile("" ::: "memory"); }
    }
};

__device__ __forceinline__ void p0_transpose_item(const float* W, int K, int N, bf16_t* WT, LAS float* scr, int item, int lane) {
    const int nblk = N / 32, kb = item / nblk, nb = item % nblk, k0 = 64 * kb, n0 = 32 * nb;
#pragma unroll 8
    for (int i = 0; i < 32; ++i) { const int kk = 2 * i + (lane >> 5); scr[kk * 33 + (lane & 31)] = W[(size_t)(k0 + kk) * N + n0 + (lane & 31)]; }
    asm volatile("s_waitcnt lgkmcnt(0)" ::: "memory");
    const int c = lane & 7;
#pragma unroll
    for (int j = 0; j < 4; ++j) { const int n = (lane >> 3) + 8 * j; const LAS float* s = scr + (8 * c) * 33 + n;
        u32x4 o; o.x = pk2(s[0 * 33], s[1 * 33]); o.y = pk2(s[2 * 33], s[3 * 33]); o.z = pk2(s[4 * 33], s[5 * 33]); o.w = pk2(s[6 * 33], s[7 * 33]);
        *(u32x4*)(WT + (size_t)(n0 + n) * K + k0 + 8 * c) = o; }
    asm volatile("s_waitcnt lgkmcnt(0)" ::: "memory");
}

__device__ __forceinline__ void phase_prologue(const Args& a, LAS unsigned char* lds, int G) {
    const int tid = threadIdx.x, wave = tid >> 6, lane = tid & 63;
    LAS float* sm = (LAS float*)lds;
    float* MOD = (float*)(a.ws + WS_MOD);
    for (int task = blockIdx.x; task < 192; task += G) {
        const int layer = task / 96, cgi = task % 96;
        for (int e = tid; e < 4096; e += 512) { const float v = a.in[1][e]; sm[e] = v / (1.0f + __expf(-v)); }
        __syncthreads();
        const int kh = lane >> 5, cl = lane & 31;
        const float* W = a.in[2] + (size_t)layer * 1024 * 3072 + cgi * 32 + cl;
        float a0 = 0.f, a1 = 0.f, a2 = 0.f, a3 = 0.f;
#pragma unroll 8
        for (int kk = 0; kk < 64; ++kk) { const int k = 128 * wave + 2 * kk + kh; const float wv = W[(size_t)k * 3072];
            a0 += sm[k] * wv; a1 += sm[1024 + k] * wv; a2 += sm[2048 + k] * wv; a3 += sm[3072 + k] * wv; }
        a0 += __shfl_xor(a0, 32); a1 += __shfl_xor(a1, 32); a2 += __shfl_xor(a2, 32); a3 += __shfl_xor(a3, 32);
        LAS float* red = sm + 4096;
        if (kh == 0) { red[(wave * 4 + 0) * 32 + cl] = a0; red[(wave * 4 + 1) * 32 + cl] = a1; red[(wave * 4 + 2) * 32 + cl] = a2; red[(wave * 4 + 3) * 32 + cl] = a3; }
        __syncthreads();
        if (tid < 128) { const int b = tid >> 5, c2 = tid & 31; float s = 0.f;
#pragma unroll
            for (int w = 0; w < 8; ++w) s += red[(w * 4 + b) * 32 + c2];
            const int col = cgi * 32 + c2; MOD[(size_t)(layer * 4 + b) * 3072 + col] = s + a.in[3][layer * 3072 + col]; }
        __syncthreads();
    }
    LAS float* scr = (LAS float*)(lds + wave * 16384);
    const int gw = blockIdx.x * 8 + wave, NGW = G * 8;
    constexpr int I_AIN = 16 * 320, I_AOUT = 16 * 32, I_BIN = 16 * 192, I_BOUT = 32 * 32, NITEMS = I_AIN + I_AOUT + I_BIN + I_BOUT;
    for (int it = gw; it < NITEMS; it += NGW) {
        int r = it;
        if (r < I_AIN) { p0_transpose_item(a.in[6], 1024, 10240, (bf16_t*)(a.ws + WS_WAIN), scr, r, lane); continue; } r -= I_AIN;
        if (r < I_AOUT) { p0_transpose_item(a.in[7], 1024, 1024, (bf16_t*)(a.ws + WS_WAOUT), scr, r, lane); continue; } r -= I_AOUT;
        if (r < I_BIN) { p0_transpose_item(a.in[8], 1024, 6144, (bf16_t*)(a.ws + WS_WBIN), scr, r, lane); continue; } r -= I_BIN;
        p0_transpose_item(a.in[13], 2048, 1024, (bf16_t*)(a.ws + WS_WBOUT), scr, r, lane);
    }
    { const int gt = blockIdx.x * 512 + tid, NT = G * 512; u32x2* o = (u32x2*)(a.ws + WS_WS);
      for (int e = gt; e < 65536; e += NT) { const f32x4 v = *(const f32x4*)(a.in[11] + (size_t)e * 4); o[e] = (u32x2){pk2(v[0], v[1]), pk2(v[2], v[3])}; } }
}

__device__ __forceinline__ void phase_h0(const Args& a, int G) {
    const int tid = threadIdx.x, wave = tid >> 6, lane = tid & 63, gw = blockIdx.x * 8 + wave, NGW = G * 8;
    const float* MOD = (const float*)(a.ws + WS_MOD); bf16_t* HB = (bf16_t*)(a.ws + WS_HB);
    for (int m = gw; m < MTOK; m += NGW) {
        const int b = m >> 13; const float* md = MOD + (size_t)b * 3072;
        const f32x4* xr = (const f32x4*)(a.in[0] + (size_t)m * DM) + lane; u32x2* o8 = (u32x2*)(HB + (size_t)m * DM) + lane;
#pragma unroll
        for (int j = 0; j < 4; ++j) { const f32x4 v = xr[64 * j]; const f32x4 sh = *((const f32x4*)md + lane + 64 * j), sc = *((const f32x4*)(md + 1024) + lane + 64 * j);
            const f32x4 h = v * (sc + 1.0f) + sh; o8[64 * j] = (u32x2){pk2(h[0], h[1]), pk2(h[2], h[3])}; }
    }
}
template <bool WITH_H>
__device__ __forceinline__ void phase_ln(const Args& a, int G, int layer) {
    const int tid = threadIdx.x, wave = tid >> 6, lane = tid & 63, gw = blockIdx.x * 8 + wave, NGW = G * 8;
    const float* MOD = (const float*)(a.ws + WS_MOD); bf16_t* HB = (bf16_t*)(a.ws + WS_HB);
    const float* lg = a.in[4] + layer * DM; const float* lb = a.in[5] + layer * DM;
    for (int m = gw; m < MTOK; m += NGW) {
        f32x4* xr = (f32x4*)(a.out + (size_t)m * DM) + lane;
        f32x4 v[4]; float s = 0.f;
#pragma unroll
        for (int j = 0; j < 4; ++j) { v[j] = xr[64 * j]; s += (v[j][0] + v[j][1]) + (v[j][2] + v[j][3]); }
        const float mean = wave_sum(s) * (1.f / DM); float s2 = 0.f;
#pragma unroll
        for (int j = 0; j < 4; ++j) { v[j] = v[j] - mean; s2 += (v[j][0] * v[j][0] + v[j][1] * v[j][1]) + (v[j][2] * v[j][2] + v[j][3] * v[j][3]); }
        const float rstd = 1.0f / sqrtf(wave_sum(s2) * (1.f / DM) + LN_EPS);
#pragma unroll
        for (int j = 0; j < 4; ++j) { const f32x4 g4 = *((const f32x4*)lg + lane + 64 * j), b4 = *((const f32x4*)lb + lane + 64 * j);
            const f32x4 x1 = v[j] * rstd * g4 + b4; xr[64 * j] = x1;
            if (WITH_H) { const int b = m >> 13; const float* md = MOD + (size_t)(4 + b) * 3072;
                const f32x4 sh = *((const f32x4*)md + lane + 64 * j), sc = *((const f32x4*)(md + 1024) + lane + 64 * j);
                const f32x4 h = x1 * (sc + 1.0f) + sh; ((u32x2*)(HB + (size_t)m * DM) + lane)[64 * j] = (u32x2){pk2(h[0], h[1]), pk2(h[2], h[3])}; } }
    }
}

#define MFMA32(a, b, c) __builtin_amdgcn_mfma_f32_32x32x16_bf16((a), (b), (c), 0, 0, 0)
__device__ __forceinline__ void phase_attn(const Args& a, LAS unsigned char* lds, int G, int half) {
    const int tid = threadIdx.x, wave = __builtin_amdgcn_readfirstlane(tid >> 6), lane = tid & 63, n = lane & 31, h = lane >> 5;
    const bf16_t* QK = (const bf16_t*)(a.ws + WS_Z);
    const bf16_t* VT = (const bf16_t*)(a.ws + WS_VT);
    bf16_t* Y = (bf16_t*)(a.ws + WS_HB) + (size_t)half * HALF_TOK * DM;
    LAS float* LSE = (LAS float*)(lds + 147456);
    const int bx = blockIdx.x; const int vcu = (G % 8 == 0) ? (bx % 8) * (G / 8) + bx / 8 : bx;
    const int kap = (n & ~12) | ((n & 4) << 1) | ((n & 8) >> 1);
    const int dperm = 32 * ((n >> 2) & 1) + (n & 3) + 4 * (n >> 3);
#pragma unroll 1
    for (int wu = vcu; wu < 256; wu += G) {
        const int bl = wu >> 7, head = (wu >> 3) & 15, span = wu & 7;
#pragma unroll 1
        for (int stage = 0; stage < 3; ++stage) {
            const int g = 2 - stage, sh = 2 * g, Lg = SEQ >> sh, nqb = 32 >> sh;
            const float slope2 = fexp2(-(float)(16 * g + head + 1) * (1.0f / 6.0f)) * LOG2E * (float)(1 << sh);
            const bf16_t* vbase = VT + (size_t)(g * 1024 + head * 64) * HALF_TOK + bl * SEQ;
#pragma unroll 1
            for (int it = 0; it < 4; ++it) {
                const int uu = wave * 4 + it, r = uu / nqb, qb = uu % nqb;
                const int q0 = ((span * 1024) >> sh) + 32 * qb;
                const int tokq = ((q0 + n) << sh) + r;
                const size_t rowq = (size_t)bl * SEQ + tokq;
                bf16x8 qf[4];
                { const bf16_t* qp = QK + rowq * NQK + (2 * g) * 1024 + head * 64 + 8 * h;
#pragma unroll
                  for (int ks = 0; ks < 4; ++ks) qf[ks] = *(const bf16x8*)(qp + 16 * ks); }
                f32x16 sc[5];
                const bf16_t* kbase = QK + (size_t)bl * SEQ * NQK + (size_t)r * NQK + (2 * g + 1) * 1024 + head * 64 + 8 * h;
                bf16x8 kf[2][4];
                { int jk = q0 - 64 + kap; jk = jk < 0 ? 0 : jk; const bf16_t* kp = kbase + ((size_t)jk << sh) * NQK;
#pragma unroll
                  for (int ks = 0; ks < 4; ++ks) kf[0][ks] = *(const bf16x8*)(kp + 16 * ks); }
#pragma unroll
                for (int c = 0; c < 5; ++c) {
                    if (c < 4) { int jk = q0 - 64 + 32 * (c + 1) + kap; jk = jk < 0 ? 0 : (jk > Lg - 1 ? Lg - 1 : jk); const bf16_t* kp = kbase + ((size_t)jk << sh) * NQK;
#pragma unroll
                        for (int ks = 0; ks < 4; ++ks) kf[(c + 1) & 1][ks] = *(const bf16x8*)(kp + 16 * ks); }
                    asm volatile("" ::: "memory");
                    f32x16 acc;
#pragma unroll
                    for (int e = 0; e < 16; ++e) acc[e] = 0.f;
#pragma unroll
                    for (int ks = 0; ks < 4; ++ks) acc = MFMA32(kf[c & 1][ks], qf[ks], acc);
                    sc[c] = acc;
                }
                const bf16_t* vp = vbase + (size_t)dperm * HALF_TOK + r * Lg;
                bf16x8 vf[2][4];
                {
#pragma unroll
                  for (int s = 0; s < 2; ++s) { int jv = q0 - 64 + 16 * s + 8 * h; jv = jv < 0 ? 0 : jv;
                      vf[0][2 * s] = *(const bf16x8*)(vp + jv); vf[0][2 * s + 1] = *(const bf16x8*)(vp + (size_t)16 * HALF_TOK + jv); } }
                asm volatile("" ::: "memory");
                int rel0 = -64 + 8 * h - n; asm volatile("" : "+v"(rel0));
                const int jq = q0 + n;
                float mx = -1e30f;
#pragma unroll
                for (int c = 0; c < 5; ++c)
#pragma unroll
                    for (int e = 0; e < 16; ++e) { const int rel = rel0 + 32 * c + 16 * (e >> 3) + (e & 7); const int kj = jq + rel; const int ar = rel < 0 ? -rel : rel;
                        const bool valid = (ar <= 64) && (kj >= 0) && (kj < Lg);
                        const float s = valid ? sc[c][e] - slope2 * (float)ar : -1e30f; sc[c][e] = s; mx = fmaxf(mx, s); }
                mx = fmaxf(mx, __shfl_xor(mx, 32));
                float den = 0.f;
#pragma unroll
                for (int c = 0; c < 5; ++c)
#pragma unroll
                    for (int e = 0; e < 16; ++e) { const float p = fexp2(sc[c][e] - mx); den += p; sc[c][e] = p; }
                den += __shfl_xor(den, 32);
                f32x16 oc[2];
#pragma unroll
                for (int e = 0; e < 16; ++e) { oc[0][e] = 0.f; oc[1][e] = 0.f; }
#pragma unroll
                for (int c = 0; c < 5; ++c) {
                    if (c < 4) {
#pragma unroll
                        for (int s = 0; s < 2; ++s) { int jv = q0 - 64 + 32 * (c + 1) + 16 * s + 8 * h; jv = jv < 0 ? 0 : (jv > Lg - 8 ? Lg - 8 : jv);
                            vf[(c + 1) & 1][2 * s] = *(const bf16x8*)(vp + jv); vf[(c + 1) & 1][2 * s + 1] = *(const bf16x8*)(vp + (size_t)16 * HALF_TOK + jv); } }
                    asm volatile("" ::: "memory");
#pragma unroll
                    for (int s = 0; s < 2; ++s) {
                        u32x4 pw; pw.x = pk2(sc[c][8 * s + 0], sc[c][8 * s + 1]); pw.y = pk2(sc[c][8 * s + 2], sc[c][8 * s + 3]); pw.z = pk2(sc[c][8 * s + 4], sc[c][8 * s + 5]); pw.w = pk2(sc[c][8 * s + 6], sc[c][8 * s + 7]);
                        const bf16x8 pb = __builtin_bit_cast(bf16x8, pw);
                        oc[0] = MFMA32(vf[c & 1][2 * s], pb, oc[0]); oc[1] = MFMA32(vf[c & 1][2 * s + 1], pb, oc[1]);
                    }
                }
                const float inv = frcp(den); float lse = mx + flog2(den);
#pragma unroll
                for (int e = 0; e < 16; ++e) { oc[0][e] *= inv; oc[1][e] *= inv; }
                const int tl = tokq - span * 1024;
                const int rho = (tl & ~15) | ((tl ^ (tl >> 4) ^ (tl >> 8)) & 15);
                LAS unsigned char* op = lds + rho * 144 + h * 64;
                if (stage > 0) {
                    const float lo = LSE[tl]; const float m2 = fmaxf(lo, lse); float wo = fexp2(lo - m2), wn = fexp2(lse - m2); const float ws = wo + wn, wi = frcp(ws);
                    lse = m2 + flog2(ws); wo *= wi; wn *= wi;
#pragma unroll
                    for (int q = 0; q < 4; ++q) { const u32x4 old = *(const LAS u32x4*)(op + q * 16);
#pragma unroll
                        for (int j = 0; j < 4; ++j) { const int e = 8 * (q & 1) + 2 * j;
                            oc[q >> 1][e] = wn * oc[q >> 1][e] + wo * bflo(old[j]); oc[q >> 1][e + 1] = wn * oc[q >> 1][e + 1] + wo * bfhi(old[j]); } }
                }
                if (stage < 2) {
#pragma unroll
                    for (int q = 0; q < 4; ++q) { const int e = 8 * (q & 1); u32x4 w; w.x = pk2(oc[q >> 1][e], oc[q >> 1][e + 1]); w.y = pk2(oc[q >> 1][e + 2], oc[q >> 1][e + 3]); w.z = pk2(oc[q >> 1][e + 4], oc[q >> 1][e + 5]); w.w = pk2(oc[q >> 1][e + 6], oc[q >> 1][e + 7]);
                        *(LAS u32x4*)(op + q * 16) = w; }
                    if (h == 0) LSE[tl] = lse;
                } else {
                    const bf16_t* sg = QK + rowq * NQK + 6144 + head * 64 + 32 * h; bf16_t* yo = Y + rowq * DM + head * 64 + 32 * h;
#pragma unroll
                    for (int q = 0; q < 4; ++q) { const u32x4 gt = *(const u32x4*)(sg + 8 * q); const int e = 8 * (q & 1); u32x4 w;
                        w.x = pk2(oc[q >> 1][e] * bflo(gt.x), oc[q >> 1][e + 1] * bfhi(gt.x)); w.y = pk2(oc[q >> 1][e + 2] * bflo(gt.y), oc[q >> 1][e + 3] * bfhi(gt.y));
                        w.z = pk2(oc[q >> 1][e + 4] * bflo(gt.z), oc[q >> 1][e + 5] * bfhi(gt.z)); w.w = pk2(oc[q >> 1][e + 6] * bflo(gt.w), oc[q >> 1][e + 7] * bfhi(gt.w));
                        *(u32x4*)(yo + 8 * q) = w; }
                }
            }
            __syncthreads();
        }
    }
}

__device__ __forceinline__ void phase_sgu(const Args& a, LAS unsigned char* lds, int G) {
    const int tid = threadIdx.x, wave = __builtin_amdgcn_readfirstlane(tid >> 6), lane = tid & 63, n = lane & 31, h = lane >> 5;
    bf16_t* Z1 = (bf16_t*)(a.ws + WS_Z); const bf16_t* VT1 = (const bf16_t*)(a.ws + WS_VT1); const bf16_t* WSb = (const bf16_t*)(a.ws + WS_WS);
    const float* STV = (const float*)(a.ws + WS_STV);
    LAS float* tokA = (LAS float*)lds; LAS float* tokB = tokA + 128;
    const int bx = blockIdx.x; const int vcu = (G % 8 == 0) ? (bx % 8) * (G / 8) + bx / 8 : bx;
    const int chrow = 16 * ((n >> 2) & 1) + 4 * (n >> 3) + (n & 3);
    for (int it = vcu; it < 2048; it += G) {
        const int nck = it >> 3, gp = it & 7;
        __syncthreads();
        if (tid < 128) { const float* sp = STV + ((size_t)(nck * 128 + tid) * 16) * 2; float s = 0.f, q = 0.f;
#pragma unroll
            for (int p = 0; p < 16; ++p) { const f32x2 v = *(const f32x2*)(sp + 2 * p); s += v.x; q += v.y; }
            const float mean = s * (1.f / 2048.f); const float var = fmaxf(q * (1.f / 2048.f) - mean * mean, 0.f); const float rstd = 1.0f / sqrtf(var + LN_EPS);
            tokA[tid] = rstd; tokB[tid] = -mean * rstd; }
        __syncthreads();
        const int g = gp * 2 + (wave >> 2), cq = wave & 3;
        const int vch = g * 128 + cq * 32 + chrow;
        const float gam = a.in[9][vch], bet = a.in[10][vch];
        const bf16_t* vptr = VT1 + (size_t)vch * MTOK + nck * 128 + 8 * h;
        const bf16_t* wptr = WSb + (size_t)(g * 128 + n) * 128 + 8 * h;
        f32x16 acc[4];
#pragma unroll
        for (int t = 0; t < 4; ++t)
#pragma unroll
            for (int e = 0; e < 16; ++e) acc[t][e] = 0.f;
#pragma unroll
        for (int ks = 0; ks < 8; ++ks) {
            const u32x4 raw = *(const u32x4*)(vptr + 16 * ks);
            const f32x4 ta0 = *(const LAS f32x4*)(tokA + 16 * ks + 8 * h), ta1 = *(const LAS f32x4*)(tokA + 16 * ks + 8 * h + 4);
            const f32x4 tb0 = *(const LAS f32x4*)(tokB + 16 * ks + 8 * h), tb1 = *(const LAS f32x4*)(tokB + 16 * ks + 8 * h + 4);
            u32x4 aw;
            aw.x = pk2((bflo(raw.x) * ta0[0] + tb0[0]) * gam + bet, (bfhi(raw.x) * ta0[1] + tb0[1]) * gam + bet);
            aw.y = pk2((bflo(raw.y) * ta0[2] + tb0[2]) * gam + bet, (bfhi(raw.y) * ta0[3] + tb0[3]) * gam + bet);
            aw.z = pk2((bflo(raw.z) * ta1[0] + tb1[0]) * gam + bet, (bfhi(raw.z) * ta1[1] + tb1[1]) * gam + bet);
            aw.w = pk2((bflo(raw.w) * ta1[2] + tb1[2]) * gam + bet, (bfhi(raw.w) * ta1[3] + tb1[3]) * gam + bet);
            const bf16x8 af = __builtin_bit_cast(bf16x8, aw);
#pragma unroll
            for (int t = 0; t < 4; ++t) { const bf16x8 wf = *(const bf16x8*)(wptr + (size_t)t * 32 * 128 + 16 * ks); acc[t] = MFMA32(af, wf, acc[t]); }
        }
        const int c0 = g * 128 + cq * 32 + 16 * h;
#pragma unroll
        for (int t = 0; t < 4; ++t) {
            const int tt = 32 * t + n; const float bias = a.in[12][g * 128 + tt];
            bf16_t* zr = Z1 + (size_t)(nck * 128 + tt) * NZ1 + c0;
#pragma unroll
            for (int q = 0; q < 2; ++q) { const u32x4 uu = *(const u32x4*)(zr + 8 * q), sg = *(const u32x4*)(zr + 2048 + 8 * q); const int e = 8 * q; u32x4 w;
                w.x = pk2(bflo(uu.x) * (acc[t][e + 0] + bias) * bflo(sg.x), bfhi(uu.x) * (acc[t][e + 1] + bias) * bfhi(sg.x));
                w.y = pk2(bflo(uu.y) * (acc[t][e + 2] + bias) * bflo(sg.y), bfhi(uu.y) * (acc[t][e + 3] + bias) * bfhi(sg.y));
                w.z = pk2(bflo(uu.z) * (acc[t][e + 4] + bias) * bflo(sg.z), bfhi(uu.z) * (acc[t][e + 5] + bias) * bfhi(sg.z));
                w.w = pk2(bflo(uu.w) * (acc[t][e + 6] + bias) * bflo(sg.w), bfhi(uu.w) * (acc[t][e + 7] + bias) * bfhi(sg.w));
                *(u32x4*)(zr + 8 * q) = w; }
        }
    }
}

__global__ void __launch_bounds__(512, 2) fwd_megakernel(Args a) {
    extern __shared__ __attribute__((aligned(16))) unsigned char lds_raw[];
    LAS unsigned char* lds = (LAS unsigned char*)lds_raw;
    const int G = gridDim.x, lo = a.ph_lo, hi = a.ph_hi;
    const char* HB = (const char*)(a.ws + WS_HB);
    const float* MOD = (const float*)(a.ws + WS_MOD);
#define IN(k) (lo <= (k) && (k) < hi)
#define SEAM(k) do { if (IN(k) && IN((k) + 1)) cg::this_grid().sync(); } while (0)
    if (IN(0)) phase_prologue(a, lds, G);
    SEAM(0);
    if (IN(1)) phase_h0(a, G);
    SEAM(1);
#pragma unroll 1
    for (int half = 0; half < 2; ++half) {
        if (IN(2 + 2 * half)) {
            SchedG1 S{G, (int)blockIdx.x, HB + (size_t)half * HALF_TOK * 2048, (const char*)(a.ws + WS_WAIN)};
            EpiG1 E{(bf16_t*)(a.ws + WS_Z), (bf16_t*)(a.ws + WS_VT)};
#ifndef NO_G1
            pg8::gemm_phase<EpiG1, SchedG1>(lds, 2048u, 1024, S, E);
#endif
        }
        SEAM(2 + 2 * half);
        #ifndef NO_ATTN
        if (IN(3 + 2 * half)) phase_attn(a, lds, G, half);
#endif
        SEAM(3 + 2 * half);
    }
    if (IN(6)) {
        SchedOut S{G, (int)blockIdx.x, HB, 2048, (const char*)(a.ws + WS_WAOUT), 2048u};
        EpiRes E{a.in[0], a.out, MOD + 2048};
#ifndef NO_G2
        pg8::gemm_phase<EpiRes, SchedOut>(lds, 2048u, 1024, S, E);
#endif
    }
    SEAM(6);
    if (IN(7)) phase_ln<true>(a, G, 0);
    SEAM(7);
    if (IN(8)) {
        SchedG3 S{G, (int)blockIdx.x, HB, (const char*)(a.ws + WS_WBIN)};
        EpiG3 E{(bf16_t*)(a.ws + WS_Z), (bf16_t*)(a.ws + WS_VT1), (float*)(a.ws + WS_STV)};
#ifndef NO_G3
        pg8::gemm_phase<EpiG3, SchedG3>(lds, 2048u, 1024, S, E);
#endif
    }
    SEAM(8);
#ifndef NO_SGU
    if (IN(9)) phase_sgu(a, lds, G);
#endif
    SEAM(9);
    if (IN(10)) {
        SchedOut S{G, (int)blockIdx.x, (const char*)(a.ws + WS_Z), 8192, (const char*)(a.ws + WS_WBOUT), 4096u};
        EpiRes E{a.out, a.out, MOD + 4 * 3072 + 2048};
#ifndef NO_G4
        pg8::gemm_phase<EpiRes, SchedOut>(lds, 8192u, 2048, S, E);
#endif
    }
    SEAM(10);
    if (IN(11)) phase_ln<false>(a, G, 1);
#undef IN
#undef SEAM
}

extern "C" void kernel_launch(void* const* d_in, const int* in_sizes, int n_in, void* d_out, int out_size, void* d_ws, size_t ws_size, hipStream_t stream) {
    static int grid = 0;
    if (grid == 0) {
        if (n_in != 14 || in_sizes[0] != MTOK * DM || out_size != MTOK * DM || ws_size < WS_END) {
            fprintf(stderr, "kernel_launch: unexpected shapes / workspace (n_in %d, in0 %d, out %d, ws %zu); nothing launched\n", n_in, n_in > 0 ? in_sizes[0] : -1, out_size, ws_size); grid = -1; return; }
        int dev = 0, cus = 0, per_cu = 0;
        if (hipGetDevice(&dev) != hipSuccess || hipDeviceGetAttribute(&cus, hipDeviceAttributeMultiprocessorCount, dev) != hipSuccess) { grid = -1; return; }
        if (hipFuncSetAttribute((const void*)fwd_megakernel, hipFuncAttributeMaxDynamicSharedMemorySize, LDS_BYTES) != hipSuccess) { fprintf(stderr, "kernel_launch: hipFuncSetAttribute failed\n"); grid = -1; return; }
        if (hipOccupancyMaxActiveBlocksPerMultiprocessor(&per_cu, (const void*)fwd_megakernel, 512, LDS_BYTES) != hipSuccess || per_cu < 1) { fprintf(stderr, "kernel_launch: occupancy query says %d\n", per_cu); per_cu = 1; }
        (void)hipGetLastError();
        grid = cus * per_cu;
        fprintf(stderr, "kernel_launch: grid %d (cus %d x %d), ws %zu\n", grid, cus, per_cu, ws_size);
    }
    if (grid < 0) return;
    Args a{};
    for (int i = 0; i < 14; ++i) a.in[i] = (const float*)d_in[i];
    a.out = (float*)d_out; a.ws = (unsigned char*)d_ws;
#if MK_MULTI
    for (int p = 0; p < NPHASE; ++p) { a.ph_lo = p; a.ph_hi = p + 1; hipLaunchKernelGGL(fwd_megakernel, dim3(grid), dim3(512), LDS_BYTES, stream, a); }
#else
    a.ph_lo = 0; a.ph_hi = NPHASE;
    void* args[] = {&a};
    hipError_t e = hipLaunchCooperativeKernel((const void*)fwd_megakernel, dim3(grid), dim3(512), args, LDS_BYTES, stream);
    if (e != hipSuccess) fprintf(stderr, "kernel_launch: cooperative launch failed: %s (grid %d)\n", hipGetErrorString(e), grid);
#endif
}
```

```cpp
#include <hip/hip_runtime.h>
#include <hip/hip_cooperative_groups.h>
#include <cstdio>
#include <cstdint>
namespace cg = cooperative_groups;

#ifndef MK_MULTI
#define MK_MULTI 0
#endif

#define LAS __attribute__((address_space(3)))
typedef unsigned short bf16_t;
typedef short bf16x8 __attribute__((ext_vector_type(8)));
typedef float f32x4 __attribute__((ext_vector_type(4)));
typedef float f32x2 __attribute__((ext_vector_type(2)));
typedef float f32x16 __attribute__((ext_vector_type(16)));
typedef unsigned u32x4 __attribute__((ext_vector_type(4)));
typedef unsigned u32x2 __attribute__((ext_vector_type(2)));
typedef __bf16 bf16x2_t __attribute__((ext_vector_type(2)));

constexpr int SEQ = 8192, DM = 1024, MTOK = 4 * SEQ;
constexpr int HALF_TOK = 16384;
constexpr int NQK = 7168;
constexpr int NZ1 = 4096;
constexpr float ALPHA = 1.41421356237309515f;
constexpr float LN_EPS = 1e-5f;
constexpr float LOG2E = 1.4426950408889634f;
constexpr float C2 = 0.125f * LOG2E;
constexpr int NPHASE = 12;

constexpr size_t MiB = 1u << 20;
constexpr size_t WS_MOD = 1 * MiB;
constexpr size_t WS_WAIN = 2 * MiB;
constexpr size_t WS_WAOUT = 22 * MiB;
constexpr size_t WS_WBIN = 24 * MiB;
constexpr size_t WS_WBOUT = 36 * MiB;
constexpr size_t WS_WS = 40 * MiB;
constexpr size_t WS_STV = 44 * MiB;
constexpr size_t WS_HB = 48 * MiB;
constexpr size_t WS_Z = 112 * MiB;
constexpr size_t WS_VT = WS_Z + 224 * MiB;
constexpr size_t WS_VT1 = WS_Z + 256 * MiB;
constexpr size_t WS_END = 496 * MiB;

constexpr int LDS_BYTES = 155648;

__device__ __forceinline__ unsigned pk2(float lo, float hi) { f32x2 v = {lo, hi}; bf16x2_t b = __builtin_convertvector(v, bf16x2_t); return __builtin_bit_cast(unsigned, b); }
__device__ __forceinline__ float bflo(unsigned u) { return __builtin_bit_cast(float, u << 16); }
__device__ __forceinline__ float bfhi(unsigned u) { return __builtin_bit_cast(float, u & 0xffff0000u); }
__device__ __forceinline__ float fexp2(float x) { return __builtin_amdgcn_exp2f(x); }
__device__ __forceinline__ float flog2(float x) { return __builtin_amdgcn_logf(x); }
__device__ __forceinline__ float frcp(float x) { return __builtin_amdgcn_rcpf(x); }
__device__ __forceinline__ float silu_f(float x) { return x * frcp(1.0f + fexp2(-x * LOG2E)); }
__device__ __forceinline__ f32x4 silu4(f32x4 v) { return (f32x4){silu_f(v[0]), silu_f(v[1]), silu_f(v[2]), silu_f(v[3])}; }
__device__ __forceinline__ float wave_sum(float v) {
#pragma unroll
    for (int o = 1; o < 64; o <<= 1) v += __shfl_xor(v, o);
    return v;
}
__device__ __forceinline__ f32x2 gelu_pk(f32x2 v) {
    const f32x2 av = __builtin_elementwise_abs(v), d = av * 0.2316418882f + 1.0f;
    f32x2 t; t.x = frcp(d.x); t.y = frcp(d.y);
    f32x2 q = t * 0.5307027145f + (-0.7265760135f); q = q * t + 0.7107068705f; q = q * t + (-0.142248368f); q = q * t + 0.127414796f; q = q * t;
    const f32x2 s = (v * v) * (-0.72134752044f);
    f32x2 e; e.x = fexp2(s.x); e.y = fexp2(s.y);
    const f32x2 m = v * (q * e), r = v - m;
    f32x2 o; o.x = v.x < 0.f ? m.x : r.x; o.y = v.y < 0.f ? m.y : r.y; return o;
}
__device__ __forceinline__ f32x4 gelu4(f32x4 v) { f32x2 a = gelu_pk((f32x2){v[0], v[1]}), b = gelu_pk((f32x2){v[2], v[3]}); return (f32x4){a.x, a.y, b.x, b.y}; }

struct Args { const float* in[14]; float* out; unsigned char* ws; int ph_lo, ph_hi; };

namespace pg8 {
constexpr int BM = 256, BK = 64, HALF = 128, HTB = HALF * BK * 2, STAGE_BYTES = 8 * HTB;
__device__ __forceinline__ int lds_byte(int r, int c) { const int st = (r >> 4) * 2 + (c >> 5), rr = r & 15, cc = c & 31, ob = rr * 64 + cc * 2; return st * 1024 + (ob ^ (((ob >> 9) & 1) << 5)); }
__device__ __forceinline__ void stage_rc(int b, int& R, int& C) { const int st = b / 1024, sb = b % 1024, swz = sb ^ (((sb >> 9) & 1) << 5); R = (st >> 1) * 16 + swz / 64; C = (st & 1) * 32 + (swz % 64) / 2; }
__device__ __forceinline__ int perm32(int rho) { const int n = rho >> 4, i = rho & 15; return 8 * (i >> 2) + 4 * n + (i & 3); }

struct Unit { const char* A; const char* B; unsigned ldb; int kind, pm, pn, g; };

__device__ __forceinline__ void static_tile(int L, int nM, int nN, int& pm, int& pn) {
    const int nwg = nM * nN; int wgid = L;
    { const int q = nwg / 8, r = nwg % 8, xcd = wgid % 8, off = wgid / 8; wgid = (xcd < r ? xcd * (q + 1) : r * (q + 1) + (xcd - r) * q) + off; }
    const int nig = 8 * nN, gid = wgid / nig, fm = gid * 8, gsz = (nM - fm) < 8 ? (nM - fm) : 8;
    pm = fm + ((wgid % nig) % gsz); pn = (wgid % nig) / gsz;
}

template <class Epi, class Sched>
__device__ __forceinline__ void gemm_phase(LAS unsigned char* lds, const unsigned lda, const int K, const Sched& S, const Epi& E) {
    const int tid = threadIdx.x, wid = __builtin_amdgcn_readfirstlane(tid >> 6), lane = tid & 63, wr = wid >> 2, wc = wid & 3, fr = lane & 15, fq = lane >> 4;
    const int nt = K / BK;
    unsigned voffA[2], rbB[2], c2B[2];
#pragma unroll
    for (int i = 0; i < 2; ++i) { int R, C; stage_rc(tid * 16 + i * 8192, R, C); const int Rb = Epi::PERM ? ((R & ~31) + perm32(R & 31)) : R;
        voffA[i] = (unsigned)R * lda + (unsigned)C * 2u; rbB[i] = (unsigned)Rb; c2B[i] = (unsigned)C * 2u; }
    const size_t kstep = (size_t)(BK * 2);
    const size_t hstepA = (size_t)HALF * lda;
    const unsigned ldsw = (unsigned)wid * 1024u;
    const int aoff = lds_byte(wr * 64 + fr, fq * 8), boff = lds_byte(wc * 32 + fr, fq * 8);
#define PG8_SA(b, h) (((b) * 2 + (h)) * HTB)
#define PG8_SB(b, h) ((4 + (b) * 2 + (h)) * HTB)
#define PG8_STAGE(bufoff, gbase, voff) do { _Pragma("unroll") for (int _i = 0; _i < 2; ++_i) \
        __builtin_amdgcn_global_load_lds((const unsigned*)((const char*)(gbase) + (voff)[_i]), (LAS unsigned*)(lds + (bufoff) + ldsw + _i * 8192), 16, 0, 0); } while (0)
#define PG8_STAGEB(bufoff, gbase, ldbv) do { _Pragma("unroll") for (int _i = 0; _i < 2; ++_i) \
        __builtin_amdgcn_global_load_lds((const unsigned*)((const char*)(gbase) + (rbB[_i] * (ldbv) + c2B[_i])), (LAS unsigned*)(lds + (bufoff) + ldsw + _i * 8192), 16, 0, 0); } while (0)
#define PG8_LDA(dst, b, h) do { _Pragma("unroll") for (int m = 0; m < 4; ++m) _Pragma("unroll") for (int k = 0; k < 2; ++k) dst[m][k] = *(const LAS bf16x8*)(lds + PG8_SA(b, h) + aoff + m * 2048 + k * 1024); } while (0)
#define PG8_LDB(dst, b, h) do { _Pragma("unroll") for (int n = 0; n < 2; ++n) _Pragma("unroll") for (int k = 0; k < 2; ++k) dst[n][k] = *(const LAS bf16x8*)(lds + PG8_SB(b, h) + boff + n * 2048 + k * 1024); } while (0)
#define PG8_MMA(ai, bj, At, Bt) do { __builtin_amdgcn_s_setprio(1); _Pragma("unroll") for (int m = 0; m < 4; ++m) _Pragma("unroll") for (int n = 0; n < 2; ++n) _Pragma("unroll") for (int k = 0; k < 2; ++k) \
        acc[ai][bj][m][n] = __builtin_amdgcn_mfma_f32_16x16x32_bf16(Bt[n][k], At[m][k], acc[ai][bj][m][n], 0, 0, 0); __builtin_amdgcn_s_setprio(0); } while (0)
#define PG8_WAIT_V(n) asm volatile("s_waitcnt vmcnt(" #n ")" ::: "memory")
#define PG8_WAIT_L(n) asm volatile("s_waitcnt lgkmcnt(" #n ")" ::: "memory")
#define PG8_BAR __builtin_amdgcn_s_barrier()
#define PG8_SCHED __builtin_amdgcn_sched_barrier(0)
    Unit cur, nxt; int ui = 0;
    if (!S.next(0, cur)) return;
    f32x4 acc[2][2][4][2];
#pragma unroll
    for (int a = 0; a < 2; ++a)
#pragma unroll
        for (int b = 0; b < 2; ++b)
#pragma unroll
            for (int m = 0; m < 4; ++m)
#pragma unroll
                for (int n = 0; n < 2; ++n) acc[a][b][m][n] = (f32x4){0.f, 0.f, 0.f, 0.f};
    bf16x8 At[4][2], B0[2][2], B1[2][2];
    const char* cA = cur.A; const char* cB = cur.B;
    unsigned ldbc = cur.ldb; size_t hBc = (size_t)HALF * ldbc;
    PG8_STAGEB(PG8_SB(0, 0), cB, ldbc); PG8_STAGEB(PG8_SB(0, 1), cB + hBc, ldbc); PG8_STAGE(PG8_SA(0, 0), cA, voffA); PG8_STAGE(PG8_SA(0, 1), cA + hstepA, voffA);
    if (wr == 1) PG8_BAR;
    PG8_WAIT_V(2); PG8_BAR;
    PG8_STAGEB(PG8_SB(1, 0), cB + kstep, ldbc); PG8_STAGE(PG8_SA(1, 0), cA + kstep, voffA); PG8_STAGEB(PG8_SB(1, 1), cB + hBc + kstep, ldbc);
    PG8_WAIT_V(6); PG8_BAR;
    for (;;) {
        const bool has_next = S.next(ui + 1, nxt);
        const char* nA = has_next ? nxt.A : cA; const char* nB = has_next ? nxt.B : cB;
        const unsigned ldbn = has_next ? nxt.ldb : ldbc; const size_t hBn = (size_t)HALF * ldbn;
        for (int t = 0; t < nt; t += 2) {
            const bool last = (t == nt - 2);
            const char* a1 = cA + (size_t)(t + 1) * kstep;
            const char* a2 = last ? nA : cA + (size_t)(t + 2) * kstep; const char* b2 = last ? nB : cB + (size_t)(t + 2) * kstep;
            const char* a3 = a2 + kstep; const char* b3 = b2 + kstep;
            const unsigned ldb2 = last ? ldbn : ldbc; const size_t hB2 = last ? hBn : hBc;
            PG8_LDB(B0, 0, 0); PG8_LDB(B1, 0, 1); PG8_SCHED; PG8_LDA(At, 0, 0); PG8_STAGE(PG8_SA(1, 1), a1 + hstepA, voffA);
            PG8_WAIT_V(8); PG8_WAIT_L(0); PG8_BAR; PG8_MMA(0, 0, At, B0); PG8_MMA(0, 1, At, B1); PG8_BAR; PG8_SCHED;
            PG8_LDA(At, 0, 1); PG8_STAGEB(PG8_SB(0, 0), b2, ldb2); PG8_STAGEB(PG8_SB(0, 1), b2 + hB2, ldb2); PG8_STAGE(PG8_SA(0, 0), a2, voffA);
            PG8_WAIT_V(8); PG8_WAIT_L(0); PG8_BAR; PG8_MMA(1, 0, At, B0); PG8_MMA(1, 1, At, B1); PG8_BAR; PG8_SCHED;
            PG8_LDB(B0, 1, 0); PG8_LDB(B1, 1, 1); PG8_SCHED; PG8_LDA(At, 1, 0); PG8_STAGE(PG8_SA(0, 1), a2 + hstepA, voffA);
            PG8_WAIT_V(8); PG8_WAIT_L(0); PG8_BAR; PG8_MMA(0, 0, At, B0); PG8_MMA(0, 1, At, B1); PG8_BAR; PG8_SCHED;
            PG8_LDA(At, 1, 1); PG8_STAGEB(PG8_SB(1, 0), b3, ldb2); PG8_STAGEB(PG8_SB(1, 1), b3 + hB2, ldb2); PG8_STAGE(PG8_SA(1, 0), a3, voffA);
            PG8_WAIT_V(8); PG8_WAIT_L(0); PG8_BAR; PG8_MMA(1, 0, At, B0); PG8_MMA(1, 1, At, B1); PG8_BAR; PG8_SCHED;
        }
        if (wr == 0) PG8_BAR;
        E(acc, cur, wr, wc, fr, fq);
        if (!has_next) break;
#pragma unroll
        for (int a = 0; a < 2; ++a)
#pragma unroll
            for (int b = 0; b < 2; ++b)
#pragma unroll
                for (int m = 0; m < 4; ++m)
#pragma unroll
                    for (int n = 0; n < 2; ++n) acc[a][b][m][n] = (f32x4){0.f, 0.f, 0.f, 0.f};
        cur = nxt; cA = nA; cB = nB; ldbc = ldbn; hBc = hBn; ++ui;
        if (wr == 1) PG8_BAR;
    }
    PG8_WAIT_V(0);
    PG8_BAR;
#undef PG8_SA
#undef PG8_SB
#undef PG8_STAGE
#undef PG8_STAGEB
#undef PG8_LDA
#undef PG8_LDB
#undef PG8_MMA
#undef PG8_WAIT_V
#undef PG8_WAIT_L
#undef PG8_BAR
#undef PG8_SCHED
}
}
using pg8::Unit;

struct SchedG1 {
    int G, c; const char* HBh; const char* W;
    __device__ __forceinline__ bool next(int i, Unit& u) const {
        const long Ll = (long)i * G + c; if (Ll >= 2560) return false;
        const int L = (int)Ll;
        if (L < 1792) {
            const int xcd = L & 7, off = L >> 3, pm = xcd * 8 + (off & 7), pn = off >> 3, seg = pn >> 2;
            const int wrow = (seg < 6 ? (seg >> 1) * 3072 + (seg & 1) * 1024 : 9216) + (pn & 3) * 256;
            u.A = HBh + (size_t)pm * 256 * 2048; u.B = W + (size_t)wrow * 2048; u.ldb = 2048u; u.kind = 0; u.pm = pm; u.pn = pn; u.g = 0;
        } else {
            int v = L - 1792; const int g = v >> 8; v &= 255;
            const int xcd = v & 7, off = v >> 3, pm = off >> 3, pn = xcd * 8 + (off & 7);
            const int sh = 2 * g, Lg = SEQ >> sh, bl = pn >> 5, vi = (pn & 31) * 256, r = vi / Lg, j0 = vi % Lg;
            const int tokrow = bl * SEQ + (j0 << sh) + r;
            u.A = W + (size_t)(g * 3072 + 2048 + pm * 256) * 2048; u.B = HBh + (size_t)tokrow * 2048; u.ldb = 2048u << sh; u.kind = 1; u.pm = pm; u.pn = pn; u.g = g;
        }
        return true;
    }
};
struct SchedG3 {
    int G, c; const char* HB; const char* W;
    __device__ __forceinline__ bool next(int i, Unit& u) const {
        const long Ll = (long)i * G + c; if (Ll >= 3072) return false;
        const int L = (int)Ll;
        if (L < 2048) {
            int pm, pn; pg8::static_tile(L, 128, 16, pm, pn);
            const int wrow = pn < 8 ? pn * 256 : 4096 + (pn - 8) * 256;
            u.A = HB + (size_t)pm * 256 * 2048; u.B = W + (size_t)wrow * 2048; u.ldb = 2048u; u.kind = 0; u.pm = pm; u.pn = pn; u.g = 0;
        } else {
            const int v = L - 2048, xcd = v & 7, off = v >> 3, pn = xcd * 16 + (off & 15), pm = off >> 4;
            u.A = W + (size_t)(2048 + pm * 256) * 2048; u.B = HB + (size_t)pn * 256 * 2048; u.ldb = 2048u; u.kind = 1; u.pm = pm; u.pn = pn; u.g = 0;
        }
        return true;
    }
};
struct SchedOut {
    int G, c; const char* A; size_t lda; const char* W; unsigned ldb;
    __device__ __forceinline__ bool next(int i, Unit& u) const {
        const long Ll = (long)i * G + c; if (Ll >= 512) return false;
        int pm, pn; pg8::static_tile((int)Ll, 128, 4, pm, pn);
        u.A = A + (size_t)pm * 256 * lda; u.B = W + (size_t)pn * 256 * ldb; u.ldb = ldb; u.kind = 0; u.pm = pm; u.pn = pn; u.g = 0;
        return true;
    }
};

struct EpiG1 {
    static constexpr bool PERM = true;
    bf16_t* QK; bf16_t* VT;
    __device__ __forceinline__ void operator()(const f32x4 (&acc)[2][2][4][2], const Unit& u, int wr, int wc, int fr, int fq) const {
        bf16_t* base; size_t ldc; int mode = 0;
        if (u.kind == 0) { base = QK; ldc = NQK; const int seg = u.pn >> 2; mode = (seg == 6) ? 2 : ((seg & 1) == 0 ? 1 : 0); }
        else { base = VT + (size_t)u.g * 1024 * HALF_TOK; ldc = HALF_TOK; }
        const int row0 = u.pm * 256 + wr * 64 + fr, col0 = u.pn * 256 + wc * 32 + 8 * fq;
#pragma unroll
        for (int ai = 0; ai < 2; ++ai)
#pragma unroll
            for (int m = 0; m < 4; ++m) { bf16_t* rowp = base + (size_t)(row0 + ai * 128 + m * 16) * ldc + col0;
#pragma unroll
                for (int bj = 0; bj < 2; ++bj) { f32x4 v0 = acc[ai][bj][m][0], v1 = acc[ai][bj][m][1];
                    if (mode == 1) { v0 = v0 * C2; v1 = v1 * C2; }
                    else if (mode == 2) { v0 = silu4(v0); v1 = silu4(v1); }
                    u32x4 w; w.x = pk2(v0[0], v0[1]); w.y = pk2(v0[2], v0[3]); w.z = pk2(v1[0], v1[1]); w.w = pk2(v1[2], v1[3]);
                    *(u32x4*)(rowp + bj * 128) = w; } }
    }
};
struct EpiG3 {
    static constexpr bool PERM = true;
    bf16_t* Z1; bf16_t* VT1; float* STV;
    __device__ __forceinline__ void operator()(const f32x4 (&acc)[2][2][4][2], const Unit& u, int wr, int wc, int fr, int fq) const {
        const int row0 = u.pm * 256 + wr * 64 + fr, col0 = u.pn * 256 + wc * 32 + 8 * fq;
        if (u.kind == 0) {
            const bool isg = u.pn >= 8;
#pragma unroll
            for (int ai = 0; ai < 2; ++ai)
#pragma unroll
                for (int m = 0; m < 4; ++m) { bf16_t* rowp = Z1 + (size_t)(row0 + ai * 128 + m * 16) * NZ1 + col0;
#pragma unroll
                    for (int bj = 0; bj < 2; ++bj) { f32x4 v0 = acc[ai][bj][m][0], v1 = acc[ai][bj][m][1];
                        if (isg) { v0 = silu4(v0); v1 = silu4(v1); } else { v0 = gelu4(v0); v1 = gelu4(v1); }
                        u32x4 w; w.x = pk2(v0[0], v0[1]); w.y = pk2(v0[2], v0[3]); w.z = pk2(v1[0], v1[1]); w.w = pk2(v1[2], v1[3]);
                        *(u32x4*)(rowp + bj * 128) = w; } }
        } else {
#pragma unroll
            for (int bj = 0; bj < 2; ++bj) {
                f32x4 s0 = {0.f, 0.f, 0.f, 0.f}, s1 = s0, q0 = s0, q1 = s0;
#pragma unroll
                for (int ai = 0; ai < 2; ++ai)
#pragma unroll
                    for (int m = 0; m < 4; ++m) { bf16_t* rowp = VT1 + (size_t)(row0 + ai * 128 + m * 16) * MTOK + col0 + bj * 128;
                        const f32x4 v0 = gelu4(acc[ai][bj][m][0]), v1 = gelu4(acc[ai][bj][m][1]);
                        s0 += v0; s1 += v1; q0 += v0 * v0; q1 += v1 * v1;
                        u32x4 w; w.x = pk2(v0[0], v0[1]); w.y = pk2(v0[2], v0[3]); w.z = pk2(v1[0], v1[1]); w.w = pk2(v1[2], v1[3]);
                        *(u32x4*)rowp = w; }
#pragma unroll
                for (int o = 1; o < 16; o <<= 1) {
#pragma unroll
                    for (int e = 0; e < 4; ++e) { s0[e] += __shfl_xor(s0[e], o); s1[e] += __shfl_xor(s1[e], o); q0[e] += __shfl_xor(q0[e], o); q1[e] += __shfl_xor(q1[e], o); } }
                if (fr == 0) { const int tok0 = col0 + bj * 128; float* sp = STV + ((size_t)tok0 * 16 + u.pm * 2 + wr) * 2;
#pragma unroll
                    for (int e = 0; e < 4; ++e) { *(f32x2*)(sp + (size_t)e * 32) = (f32x2){s0[e], q0[e]}; *(f32x2*)(sp + (size_t)(4 + e) * 32) = (f32x2){s1[e], q1[e]}; } }
            }
        }
    }
};
struct EpiRes {
    static constexpr bool PERM = false;
    const float* res; float* dst; const float* gate;
    __device__ __forceinline__ void operator()(const f32x4 (&acc)[2][2][4][2], const Unit& u, int wr, int wc, int fr, int fq) const {
        const int col0 = u.pn * 256 + wc * 32 + 4 * fq; const float* gp = gate + (size_t)(u.pm >> 5) * 3072 + col0;
        f32x4 gv[2][2];
#pragma unroll
        for (int bj = 0; bj < 2; ++bj)
#pragma unroll
            for (int n = 0; n < 2; ++n) gv[bj][n] = *(const f32x4*)(gp + bj * 128 + n * 16);
#pragma unroll
        for (int ai = 0; ai < 2; ++ai)
#pragma unroll
            for (int m = 0; m < 4; ++m) { const size_t off = (size_t)(u.pm * 256 + ai * 128 + wr * 64 + m * 16 + fr) * DM + col0;
#pragma unroll
                for (int bj = 0; bj < 2; ++bj)
#pragma unroll
                    for (int n = 0; n < 2; ++n) { const f32x4 r = *(const f32x4*)(res + off + bj * 128 + n * 16);
                        *(f32x4*)(dst + off + bj * 128 + n * 16) = r * ALPHA + gv[bj][n] * acc[ai][bj][m][n]; }
                asm volatile("" ::: "memory"); }
    }
};

__device__ __forceinline__ void p0_transpose_item(const float* W, int K, int N, bf16_t* WT, LAS float* scr, int item, int lane) {
    const int nblk = N / 32, kb = item / nblk, nb = item % nblk, k0 = 64 * kb, n0 = 32 * nb;
#pragma unroll 8
    for (int i = 0; i < 32; ++i) { const int kk = 2 * i + (lane >> 5); scr[kk * 33 + (lane & 31)] = W[(size_t)(k0 + kk) * N + n0 + (lane & 31)]; }
    asm volatile("s_waitcnt lgkmcnt(0)" ::: "memory");
    const int c = lane & 7;
#pragma unroll
    for (int j = 0; j < 4; ++j) { const int n = (lane >> 3) + 8 * j; const LAS float* s = scr + (8 * c) * 33 + n;
        u32x4 o; o.x = pk2(s[0 * 33], s[1 * 33]); o.y = pk2(s[2 * 33], s[3 * 33]); o.z = pk2(s[4 * 33], s[5 * 33]); o.w = pk2(s[6 * 33], s[7 * 33]);
        *(u32x4*)(WT + (size_t)(n0 + n) * K + k0 + 8 * c) = o; }
    asm volatile("s_waitcnt lgkmcnt(0)" ::: "memory");
}

__device__ __forceinline__ void phase_prologue(const Args& a, LAS unsigned char* lds, int G) {
    const int tid = threadIdx.x, wave = tid >> 6, lane = tid & 63;
    LAS float* sm = (LAS float*)lds;
    float* MOD = (float*)(a.ws + WS_MOD);
    for (int task = blockIdx.x; task < 192; task += G) {
        const int layer = task / 96, cgi = task % 96;
        for (int e = tid; e < 4096; e += 512) { const float v = a.in[1][e]; sm[e] = v / (1.0f + __expf(-v)); }
        __syncthreads();
        const int kh = lane >> 5, cl = lane & 31;
        const float* W = a.in[2] + (size_t)layer * 1024 * 3072 + cgi * 32 + cl;
        float a0 = 0.f, a1 = 0.f, a2 = 0.f, a3 = 0.f;
#pragma unroll 8
        for (int kk = 0; kk < 64; ++kk) { const int k = 128 * wave + 2 * kk + kh; const float wv = W[(size_t)k * 3072];
            a0 += sm[k] * wv; a1 += sm[1024 + k] * wv; a2 += sm[2048 + k] * wv; a3 += sm[3072 + k] * wv; }
        a0 += __shfl_xor(a0, 32); a1 += __shfl_xor(a1, 32); a2 += __shfl_xor(a2, 32); a3 += __shfl_xor(a3, 32);
        LAS float* red = sm + 4096;
        if (kh == 0) { red[(wave * 4 + 0) * 32 + cl] = a0; red[(wave * 4 + 1) * 32 + cl] = a1; red[(wave * 4 + 2) * 32 + cl] = a2; red[(wave * 4 + 3) * 32 + cl] = a3; }
        __syncthreads();
        if (tid < 128) { const int b = tid >> 5, c2 = tid & 31; float s = 0.f;
#pragma unroll
            for (int w = 0; w < 8; ++w) s += red[(w * 4 + b) * 32 + c2];
            const int col = cgi * 32 + c2; MOD[(size_t)(layer * 4 + b) * 3072 + col] = s + a.in[3][layer * 3072 + col]; }
        __syncthreads();
    }
    LAS float* scr = (LAS float*)(lds + wave * 16384);
    const int gw = blockIdx.x * 8 + wave, NGW = G * 8;
    constexpr int I_AIN = 16 * 320, I_AOUT = 16 * 32, I_BIN = 16 * 192, I_BOUT = 32 * 32, NITEMS = I_AIN + I_AOUT + I_BIN + I_BOUT;
    for (int it = gw; it < NITEMS; it += NGW) {
        int r = it;
        if (r < I_AIN) { p0_transpose_item(a.in[6], 1024, 10240, (bf16_t*)(a.ws + WS_WAIN), scr, r, lane); continue; } r -= I_AIN;
        if (r < I_AOUT) { p0_transpose_item(a.in[7], 1024, 1024, (bf16_t*)(a.ws + WS_WAOUT), scr, r, lane); continue; } r -= I_AOUT;
        if (r < I_BIN) { p0_transpose_item(a.in[8], 1024, 6144, (bf16_t*)(a.ws + WS_WBIN), scr, r, lane); continue; } r -= I_BIN;
        p0_transpose_item(a.in[13], 2048, 1024, (bf16_t*)(a.ws + WS_WBOUT), scr, r, lane);
    }
    { const int gt = blockIdx.x * 512 + tid, NT = G * 512; u32x2* o = (u32x2*)(a.ws + WS_WS);
      for (int e = gt; e < 65536; e += NT) { const f32x4 v = *(const f32x4*)(a.in[11] + (size_t)e * 4); o[e] = (u32x2){pk2(v[0], v[1]), pk2(v[2], v[3])}; } }
}

__device__ __forceinline__ void phase_h0(const Args& a, int G) {
    const int tid = threadIdx.x, wave = tid >> 6, lane = tid & 63, gw = blockIdx.x * 8 + wave, NGW = G * 8;
    const float* MOD = (const float*)(a.ws + WS_MOD); bf16_t* HB = (bf16_t*)(a.ws + WS_HB);
    for (int m = gw; m < MTOK; m += NGW) {
        const int b = m >> 13; const float* md = MOD + (size_t)b * 3072;
        const f32x4* xr = (const f32x4*)(a.in[0] + (size_t)m * DM) + lane; u32x2* o8 = (u32x2*)(HB + (size_t)m * DM) + lane;
#pragma unroll
        for (int j = 0; j < 4; ++j) { const f32x4 v = xr[64 * j]; const f32x4 sh = *((const f32x4*)md + lane + 64 * j), sc = *((const f32x4*)(md + 1024) + lane + 64 * j);
            const f32x4 h = v * (sc + 1.0f) + sh; o8[64 * j] = (u32x2){pk2(h[0], h[1]), pk2(h[2], h[3])}; }
    }
}
template <bool WITH_H>
__device__ __forceinline__ void phase_ln(const Args& a, int G, int layer) {
    const int tid = threadIdx.x, wave = tid >> 6, lane = tid & 63, gw = blockIdx.x * 8 + wave, NGW = G * 8;
    const float* MOD = (const float*)(a.ws + WS_MOD); bf16_t* HB = (bf16_t*)(a.ws + WS_HB);
    const float* lg = a.in[4] + layer * DM; const float* lb = a.in[5] + layer * DM;
    for (int m = gw; m < MTOK; m += NGW) {
        f32x4* xr = (f32x4*)(a.out + (size_t)m * DM) + lane;
        f32x4 v[4]; float s = 0.f;
#pragma unroll
        for (int j = 0; j < 4; ++j) { v[j] = xr[64 * j]; s += (v[j][0] + v[j][1]) + (v[j][2] + v[j][3]); }
        const float mean = wave_sum(s) * (1.f / DM); float s2 = 0.f;
#pragma unroll
        for (int j = 0; j < 4; ++j) { v[j] = v[j] - mean; s2 += (v[j][0] * v[j][0] + v[j][1] * v[j][1]) + (v[j][2] * v[j][2] + v[j][3] * v[j][3]); }
        const float rstd = 1.0f / sqrtf(wave_sum(s2) * (1.f / DM) + LN_EPS);
#pragma unroll
        for (int j = 0; j < 4; ++j) { const f32x4 g4 = *((const f32x4*)lg + lane + 64 * j), b4 = *((const f32x4*)lb + lane + 64 * j);
            const f32x4 x1 = v[j] * rstd * g4 + b4; xr[64 * j] = x1;
            if (WITH_H) { const int b = m >> 13; const float* md = MOD + (size_t)(4 + b) * 3072;
                const f32x4 sh = *((const f32x4*)md + lane + 64 * j), sc = *((const f32x4*)(md + 1024) + lane + 64 * j);
                const f32x4 h = x1 * (sc + 1.0f) + sh; ((u32x2*)(HB + (size_t)m * DM) + lane)[64 * j] = (u32x2){pk2(h[0], h[1]), pk2(h[2], h[3])}; } }
    }
}

#define MFMA32(a, b, c) __builtin_amdgcn_mfma_f32_32x32x16_bf16((a), (b), (c), 0, 0, 0)
__device__ __forceinline__ void phase_attn(const Args& a, LAS unsigned char* lds, int G, int half) {
    const int tid = threadIdx.x, wave = __builtin_amdgcn_readfirstlane(tid >> 6), lane = tid & 63, n = lane & 31, h = lane >> 5;
    const bf16_t* QK = (const bf16_t*)(a.ws + WS_Z);
    const bf16_t* VT = (const bf16_t*)(a.ws + WS_VT);
    bf16_t* Y = (bf16_t*)(a.ws + WS_HB) + (size_t)half * HALF_TOK * DM;
    LAS float* LSE = (LAS float*)(lds + 147456);
    const int bx = blockIdx.x; const int vcu = (G % 8 == 0) ? (bx % 8) * (G / 8) + bx / 8 : bx;
    const int kap = (n & ~12) | ((n & 4) << 1) | ((n & 8) >> 1);
    const int dperm = 32 * ((n >> 2) & 1) + (n & 3) + 4 * (n >> 3);
#pragma unroll 1
    for (int wu = vcu; wu < 256; wu += G) {
        const int bl = wu >> 7, head = (wu >> 3) & 15, span = wu & 7;
#pragma unroll 1
        for (int stage = 0; stage < 3; ++stage) {
            const int g = 2 - stage, sh = 2 * g, Lg = SEQ >> sh, nqb = 32 >> sh;
            const float slope2 = fexp2(-(float)(16 * g + head + 1) * (1.0f / 6.0f)) * LOG2E * (float)(1 << sh);
            const bf16_t* vbase = VT + (size_t)(g * 1024 + head * 64) * HALF_TOK + bl * SEQ;
#pragma unroll 1
            for (int it = 0; it < 4; ++it) {
                const int uu = wave * 4 + it, r = uu / nqb, qb = uu % nqb;
                const int q0 = ((span * 1024) >> sh) + 32 * qb;
                const int tokq = ((q0 + n) << sh) + r;
                const size_t rowq = (size_t)bl * SEQ + tokq;
                bf16x8 qf[4];
                { const bf16_t* qp = QK + rowq * NQK + (2 * g) * 1024 + head * 64 + 8 * h;
#pragma unroll
                  for (int ks = 0; ks < 4; ++ks) qf[ks] = *(const bf16x8*)(qp + 16 * ks); }
                f32x16 sc[5];
                const bf16_t* kbase = QK + (size_t)bl * SEQ * NQK + (size_t)r * NQK + (2 * g + 1) * 1024 + head * 64 + 8 * h;
                bf16x8 kf[2][4];
                { int jk = q0 - 64 + kap; jk = jk < 0 ? 0 : jk; const bf16_t* kp = kbase + ((size_t)jk << sh) * NQK;
#pragma unroll
                  for (int ks = 0; ks < 4; ++ks) kf[0][ks] = *(const bf16x8*)(kp + 16 * ks); }
#pragma unroll
                for (int c = 0; c < 5; ++c) {
                    if (c < 4) { int jk = q0 - 64 + 32 * (c + 1) + kap; jk = jk < 0 ? 0 : (jk > Lg - 1 ? Lg - 1 : jk); const bf16_t* kp = kbase + ((size_t)jk << sh) * NQK;
#pragma unroll
                        for (int ks = 0; ks < 4; ++ks) kf[(c + 1) & 1][ks] = *(const bf16x8*)(kp + 16 * ks); }
                    asm volatile("" ::: "memory");
                    f32x16 acc;
#pragma unroll
                    for (int e = 0; e < 16; ++e) acc[e] = 0.f;
#pragma unroll
                    for (int ks = 0; ks < 4; ++ks) acc = MFMA32(kf[c & 1][ks], qf[ks], acc);
                    sc[c] = acc;
                }
                const bf16_t* vp = vbase + (size_t)dperm * HALF_TOK + r * Lg;
                bf16x8 vf[2][4];
                {
#pragma unroll
                  for (int s = 0; s < 2; ++s) { int jv = q0 - 64 + 16 * s + 8 * h; jv = jv < 0 ? 0 : jv;
                      vf[0][2 * s] = *(const bf16x8*)(vp + jv); vf[0][2 * s + 1] = *(const bf16x8*)(vp + (size_t)16 * HALF_TOK + jv); } }
                asm volatile("" ::: "memory");
                int rel0 = -64 + 8 * h - n; asm volatile("" : "+v"(rel0));
                const int jq = q0 + n;
                float mx = -1e30f;
#pragma unroll
                for (int c = 0; c < 5; ++c)
#pragma unroll
                    for (int e = 0; e < 16; ++e) { const int rel = rel0 + 32 * c + 16 * (e >> 3) + (e & 7); const int kj = jq + rel; const int ar = rel < 0 ? -rel : rel;
                        const bool valid = (ar <= 64) && (kj >= 0) && (kj < Lg);
                        const float s = valid ? sc[c][e] - slope2 * (float)ar : -1e30f; sc[c][e] = s; mx = fmaxf(mx, s); }
                mx = fmaxf(mx, __shfl_xor(mx, 32));
                float den = 0.f;
#pragma unroll
                for (int c = 0; c < 5; ++c)
#pragma unroll
                    for (int e = 0; e < 16; ++e) { const float p = fexp2(sc[c][e] - mx); den += p; sc[c][e] = p; }
                den += __shfl_xor(den, 32);
                f32x16 oc[2];
#pragma unroll
                for (int e = 0; e < 16; ++e) { oc[0][e] = 0.f; oc[1][e] = 0.f; }
#pragma unroll
                for (int c = 0; c < 5; ++c) {
                    if (c < 4) {
#pragma unroll
                        for (int s = 0; s < 2; ++s) { int jv = q0 - 64 + 32 * (c + 1) + 16 * s + 8 * h; jv = jv < 0 ? 0 : (jv > Lg - 8 ? Lg - 8 : jv);
                            vf[(c + 1) & 1][2 * s] = *(const bf16x8*)(vp + jv); vf[(c + 1) & 1][2 * s + 1] = *(const bf16x8*)(vp + (size_t)16 * HALF_TOK + jv); } }
                    asm volatile("" ::: "memory");
#pragma unroll
                    for (int s = 0; s < 2; ++s) {
                        u32x4 pw; pw.x = pk2(sc[c][8 * s + 0], sc[c][8 * s + 1]); pw.y = pk2(sc[c][8 * s + 2], sc[c][8 * s + 3]); pw.z = pk2(sc[c][8 * s + 4], sc[c][8 * s + 5]); pw.w = pk2(sc[c][8 * s + 6], sc[c][8 * s + 7]);
                        const bf16x8 pb = __builtin_bit_cast(bf16x8, pw);
                        oc[0] = MFMA32(vf[c & 1][2 * s], pb, oc[0]); oc[1] = MFMA32(vf[c & 1][2 * s + 1], pb, oc[1]);
                    }
                }
                const float inv = frcp(den); float lse = mx + flog2(den);
#pragma unroll
                for (int e = 0; e < 16; ++e) { oc[0][e] *= inv; oc[1][e] *= inv; }
                const int tl = tokq - span * 1024;
                const int rho = (tl & ~15) | ((tl ^ (tl >> 4) ^ (tl >> 8)) & 15);
                LAS unsigned char* op = lds + rho * 144 + h * 64;
                if (stage > 0) {
                    const float lo = LSE[tl]; const float m2 = fmaxf(lo, lse); float wo = fexp2(lo - m2), wn = fexp2(lse - m2); const float ws = wo + wn, wi = frcp(ws);
                    lse = m2 + flog2(ws); wo *= wi; wn *= wi;
#pragma unroll
                    for (int q = 0; q < 4; ++q) { const u32x4 old = *(const LAS u32x4*)(op + q * 16);
#pragma unroll
                        for (int j = 0; j < 4; ++j) { const int e = 8 * (q & 1) + 2 * j;
                            oc[q >> 1][e] = wn * oc[q >> 1][e] + wo * bflo(old[j]); oc[q >> 1][e + 1] = wn * oc[q >> 1][e + 1] + wo * bfhi(old[j]); } }
                }
                if (stage < 2) {
#pragma unroll
                    for (int q = 0; q < 4; ++q) { const int e = 8 * (q & 1); u32x4 w; w.x = pk2(oc[q >> 1][e], oc[q >> 1][e + 1]); w.y = pk2(oc[q >> 1][e + 2], oc[q >> 1][e + 3]); w.z = pk2(oc[q >> 1][e + 4], oc[q >> 1][e + 5]); w.w = pk2(oc[q >> 1][e + 6], oc[q >> 1][e + 7]);
                        *(LAS u32x4*)(op + q * 16) = w; }
                    if (h == 0) LSE[tl] = lse;
                } else {
                    const bf16_t* sg = QK + rowq * NQK + 6144 + head * 64 + 32 * h; bf16_t* yo = Y + rowq * DM + head * 64 + 32 * h;
#pragma unroll
                    for (int q = 0; q < 4; ++q) { const u32x4 gt = *(const u32x4*)(sg + 8 * q); const int e = 8 * (q & 1); u32x4 w;
                        w.x = pk2(oc[q >> 1][e] * bflo(gt.x), oc[q >> 1][e + 1] * bfhi(gt.x)); w.y = pk2(oc[q >> 1][e + 2] * bflo(gt.y), oc[q >> 1][e + 3] * bfhi(gt.y));
                        w.z = pk2(oc[q >> 1][e + 4] * bflo(gt.z), oc[q >> 1][e + 5] * bfhi(gt.z)); w.w = pk2(oc[q >> 1][e + 6] * bflo(gt.w), oc[q >> 1][e + 7] * bfhi(gt.w));
                        *(u32x4*)(yo + 8 * q) = w; }
                }
            }
            __syncthreads();
        }
    }
}

__device__ __forceinline__ void phase_sgu(const Args& a, LAS unsigned char* lds, int G) {
    const int tid = threadIdx.x, wave = __builtin_amdgcn_readfirstlane(tid >> 6), lane = tid & 63, n = lane & 31, h = lane >> 5;
    bf16_t* Z1 = (bf16_t*)(a.ws + WS_Z); const bf16_t* VT1 = (const bf16_t*)(a.ws + WS_VT1); const bf16_t* WSb = (const bf16_t*)(a.ws + WS_WS);
    const float* STV = (const float*)(a.ws + WS_STV);
    LAS float* tokA = (LAS float*)lds; LAS float* tokB = tokA + 128;
    const int bx = blockIdx.x; const int vcu = (G % 8 == 0) ? (bx % 8) * (G / 8) + bx / 8 : bx;
    const int chrow = 16 * ((n >> 2) & 1) + 4 * (n >> 3) + (n & 3);
    for (int it = vcu; it < 2048; it += G) {
        const int nck = it >> 3, gp = it & 7;
        __syncthreads();
        if (tid < 128) { const float* sp = STV + ((size_t)(nck * 128 + tid) * 16) * 2; float s = 0.f, q = 0.f;
#pragma unroll
            for (int p = 0; p < 16; ++p) { const f32x2 v = *(const f32x2*)(sp + 2 * p); s += v.x; q += v.y; }
            const float mean = s * (1.f / 2048.f); const float var = fmaxf(q * (1.f / 2048.f) - mean * mean, 0.f); const float rstd = 1.0f / sqrtf(var + LN_EPS);
            tokA[tid] = rstd; tokB[tid] = -mean * rstd; }
        __syncthreads();
        const int g = gp * 2 + (wave >> 2), cq = wave & 3;
        const int vch = g * 128 + cq * 32 + chrow;
        const float gam = a.in[9][vch], bet = a.in[10][vch];
        const bf16_t* vptr = VT1 + (size_t)vch * MTOK + nck * 128 + 8 * h;
        const bf16_t* wptr = WSb + (size_t)(g * 128 + n) * 128 + 8 * h;
        f32x16 acc[4];
#pragma unroll
        for (int t = 0; t < 4; ++t)
#pragma unroll
            for (int e = 0; e < 16; ++e) acc[t][e] = 0.f;
#pragma unroll
        for (int ks = 0; ks < 8; ++ks) {
            const u32x4 raw = *(const u32x4*)(vptr + 16 * ks);
            const f32x4 ta0 = *(const LAS f32x4*)(tokA + 16 * ks + 8 * h), ta1 = *(const LAS f32x4*)(tokA + 16 * ks + 8 * h + 4);
            const f32x4 tb0 = *(const LAS f32x4*)(tokB + 16 * ks + 8 * h), tb1 = *(const LAS f32x4*)(tokB + 16 * ks + 8 * h + 4);
            u32x4 aw;
            aw.x = pk2((bflo(raw.x) * ta0[0] + tb0[0]) * gam + bet, (bfhi(raw.x) * ta0[1] + tb0[1]) * gam + bet);
            aw.y = pk2((bflo(raw.y) * ta0[2] + tb0[2]) * gam + bet, (bfhi(raw.y) * ta0[3] + tb0[3]) * gam + bet);
            aw.z = pk2((bflo(raw.z) * ta1[0] + tb1[0]) * gam + bet, (bfhi(raw.z) * ta1[1] + tb1[1]) * gam + bet);
            aw.w = pk2((bflo(raw.w) * ta1[2] + tb1[2]) * gam + bet, (bfhi(raw.w) * ta1[3] + tb1[3]) * gam + bet);
            const bf16x8 af = __builtin_bit_cast(bf16x8, aw);
#pragma unroll
            for (int t = 0; t < 4; ++t) { const bf16x8 wf = *(const bf16x8*)(wptr + (size_t)t * 32 * 128 + 16 * ks); acc[t] = MFMA32(af, wf, acc[t]); }
        }
        const int c0 = g * 128 + cq * 32 + 16 * h;
#pragma unroll
        for (int t = 0; t < 4; ++t) {
            const int tt = 32 * t + n; const float bias = a.in[12][g * 128 + tt];
            bf16_t* zr = Z1 + (size_t)(nck * 128 + tt) * NZ1 + c0;
#pragma unroll
            for (int q = 0; q < 2; ++q) { const u32x4 uu = *(const u32x4*)(zr + 8 * q), sg = *(const u32x4*)(zr + 2048 + 8 * q); const int e = 8 * q; u32x4 w;
                w.x = pk2(bflo(uu.x) * (acc[t][e + 0] + bias) * bflo(sg.x), bfhi(uu.x) * (acc[t][e + 1] + bias) * bfhi(sg.x));
                w.y = pk2(bflo(uu.y) * (acc[t][e + 2] + bias) * bflo(sg.y), bfhi(uu.y) * (acc[t][e + 3] + bias) * bfhi(sg.y));
                w.z = pk2(bflo(uu.z) * (acc[t][e + 4] + bias) * bflo(sg.z), bfhi(uu.z) * (acc[t][e + 5] + bias) * bfhi(sg.z));
                w.w = pk2(bflo(uu.w) * (acc[t][e + 6] + bias) * bflo(sg.w), bfhi(uu.w) * (acc[t][e + 7] + bias) * bfhi(sg.w));
                *(u32x4*)(zr + 8 * q) = w; }
        }
    }
}

#define XB_TMO      128
#define XB_XCNT(j)  (256  + 64 * (j))
#define XB_XSUB(j)  (1280 + 64 * (j))
#define XB_XGEN(j)  (2304 + 64 * (j))
#define XB_TOP      3328
#define XB_TOPGEN   3392
#define XCD_BAR_WORDS 3456
#define XB_SPIN_CAP (1u << 18)
__device__ __forceinline__ unsigned xb_ld(unsigned* p)              { return __hip_atomic_load(p, __ATOMIC_RELAXED, __HIP_MEMORY_SCOPE_AGENT); }
__device__ __forceinline__ unsigned xb_add(unsigned* p, unsigned v) { return __hip_atomic_fetch_add(p, v, __ATOMIC_RELAXED, __HIP_MEMORY_SCOPE_AGENT); }
__device__ __forceinline__ unsigned xb_xcc_id() { return (unsigned)__builtin_amdgcn_s_getreg((3 << 11) | 20) & 0xFu; }
#define XB_SPIN(cond, bar) do { unsigned _sp = 0; while (cond) { __builtin_amdgcn_s_sleep(1); \
    if ((++_sp & 255u) == 0u) { if (xb_ld(&(bar)[XB_TMO])) break; if (_sp > XB_SPIN_CAP) { atomicAdd(&(bar)[XB_TMO], 1u); break; } } } } while (0)
struct XcdBarrier { unsigned* bar; unsigned x; volatile LAS unsigned* st; };
__device__ __forceinline__ XcdBarrier xcd_barrier_post(unsigned* bar, volatile LAS unsigned* st) {
    XcdBarrier b; b.bar = bar; b.x = xb_xcc_id(); b.st = st;
    if (threadIdx.x == 0) (void)xb_add(&bar[XB_XCNT(b.x)], 1u);
    return b;
}
__device__ __forceinline__ void xcd_barrier_complete(unsigned* bar, unsigned x, unsigned& nloc, unsigned& nx) {
    const unsigned G = gridDim.x * gridDim.y * gridDim.z;
    unsigned sum, cnt, mine, sp = 0u;
    for (;;) {
        sum = 0u; cnt = 0u; mine = 0u;
#pragma unroll
        for (unsigned j = 0; j < 16; ++j) { const unsigned c = xb_ld(&bar[XB_XCNT(j)]); sum += c; cnt += (c > 0u) ? 1u : 0u; mine = (j == x) ? c : mine; }
        if (sum == G) break;
        __builtin_amdgcn_s_sleep(1);
        if ((++sp & 255u) == 0u) { if (xb_ld(&bar[XB_TMO])) break; if (sp > XB_SPIN_CAP) { atomicAdd(&bar[XB_TMO], 1u); break; } }
    }
    nloc = mine > 0u ? mine : 1u; nx = cnt > 0u ? cnt : 1u;
}
__device__ __forceinline__ void xcd_barrier(const XcdBarrier& b) {
    asm volatile("s_waitcnt vmcnt(0)" ::: "memory");
    __syncthreads();
    if (threadIdx.x == 0) {
        unsigned* bar = b.bar;
        __builtin_amdgcn_s_waitcnt(0);
        unsigned nloc = b.st[0], nx = b.st[1];
        if (nloc == 0u) { xcd_barrier_complete(bar, b.x, nloc, nx); b.st[0] = nloc; b.st[1] = nx; }
        const unsigned old = xb_add(&bar[XB_XSUB(b.x)], 1u);
        const unsigned gen = old / nloc;
        if (old + 1u == (gen + 1u) * nloc) {
            __builtin_amdgcn_fence(__ATOMIC_RELEASE, "agent");
            asm volatile("s_waitcnt vmcnt(0)" ::: "memory");
            const unsigned og = xb_add(&bar[XB_TOP], 1u);
            const unsigned tg = og / nx;
            if (og + 1u == (tg + 1u) * nx) xb_add(&bar[XB_TOPGEN], 1u);
            else XB_SPIN(xb_ld(&bar[XB_TOPGEN]) == tg, bar);
            __builtin_amdgcn_fence(__ATOMIC_ACQUIRE, "agent");
            xb_add(&bar[XB_XGEN(b.x)], 1u);
            asm volatile("s_waitcnt vmcnt(0)" ::: "memory");
        } else {
            XB_SPIN(xb_ld(&bar[XB_XGEN(b.x)]) == gen, bar);
            __builtin_amdgcn_fence(__ATOMIC_ACQUIRE, "agent");
            asm volatile("s_waitcnt vmcnt(0)" ::: "memory");
        }
    }
    __syncthreads();
}

__global__ void __launch_bounds__(512, 2) fwd_megakernel(Args a) {
    extern __shared__ __attribute__((aligned(16))) unsigned char lds_raw[];
    LAS unsigned char* lds = (LAS unsigned char*)lds_raw;
    const int G = gridDim.x, lo = a.ph_lo, hi = a.ph_hi;
    const char* HB = (const char*)(a.ws + WS_HB);
    const float* MOD = (const float*)(a.ws + WS_MOD);
#define IN(k) (lo <= (k) && (k) < hi)
#define SEAM(k) do { if (IN(k) && IN((k) + 1)) xcd_barrier(bar); } while (0)
    volatile LAS unsigned* bst = (volatile LAS unsigned*)(lds + 151552 + 64);
    if (threadIdx.x < 2) bst[threadIdx.x] = 0u;
    __syncthreads();
    XcdBarrier bar = xcd_barrier_post((unsigned*)a.ws, bst);
    if (a.ph_hi > 1000) cg::this_grid().sync();
    if (IN(0)) phase_prologue(a, lds, G);
    SEAM(0);
    if (IN(1)) phase_h0(a, G);
    SEAM(1);
#pragma unroll 1
    for (int half = 0; half < 2; ++half) {
        if (IN(2 + 2 * half)) {
            SchedG1 S{G, (int)blockIdx.x, HB + (size_t)half * HALF_TOK * 2048, (const char*)(a.ws + WS_WAIN)};
            EpiG1 E{(bf16_t*)(a.ws + WS_Z), (bf16_t*)(a.ws + WS_VT)};
#ifndef NO_G1
            pg8::gemm_phase<EpiG1, SchedG1>(lds, 2048u, 1024, S, E);
#endif
        }
        SEAM(2 + 2 * half);
        #ifndef NO_ATTN
        if (IN(3 + 2 * half)) phase_attn(a, lds, G, half);
#endif
        SEAM(3 + 2 * half);
    }
    if (IN(6)) {
        SchedOut S{G, (int)blockIdx.x, HB, 2048, (const char*)(a.ws + WS_WAOUT), 2048u};
        EpiRes E{a.in[0], a.out, MOD + 2048};
#ifndef NO_G2
        pg8::gemm_phase<EpiRes, SchedOut>(lds, 2048u, 1024, S, E);
#endif
    }
    SEAM(6);
    if (IN(7)) phase_ln<true>(a, G, 0);
    SEAM(7);
    if (IN(8)) {
        SchedG3 S{G, (int)blockIdx.x, HB, (const char*)(a.ws + WS_WBIN)};
        EpiG3 E{(bf16_t*)(a.ws + WS_Z), (bf16_t*)(a.ws + WS_VT1), (float*)(a.ws + WS_STV)};
#ifndef NO_G3
        pg8::gemm_phase<EpiG3, SchedG3>(lds, 2048u, 1024, S, E);
#endif
    }
    SEAM(8);
#ifndef NO_SGU
    if (IN(9)) phase_sgu(a, lds, G);
#endif
    SEAM(9);
    if (IN(10)) {
        SchedOut S{G, (int)blockIdx.x, (const char*)(a.ws + WS_Z), 8192, (const char*)(a.ws + WS_WBOUT), 4096u};
        EpiRes E{a.out, a.out, MOD + 4 * 3072 + 2048};
#ifndef NO_G4
        pg8::gemm_phase<EpiRes, SchedOut>(lds, 8192u, 2048, S, E);
#endif
    }
    SEAM(10);
    if (IN(11)) phase_ln<false>(a, G, 1);
#undef IN
#undef SEAM
}

extern "C" void kernel_launch(void* const* d_in, const int* in_sizes, int n_in, void* d_out, int out_size, void* d_ws, size_t ws_size, hipStream_t stream) {
    static int grid = 0;
    if (grid == 0) {
        if (n_in != 14 || in_sizes[0] != MTOK * DM || out_size != MTOK * DM || ws_size < WS_END) {
            fprintf(stderr, "kernel_launch: unexpected shapes / workspace (n_in %d, in0 %d, out %d, ws %zu); nothing launched\n", n_in, n_in > 0 ? in_sizes[0] : -1, out_size, ws_size); grid = -1; return; }
        int dev = 0, cus = 0, per_cu = 0;
        if (hipGetDevice(&dev) != hipSuccess || hipDeviceGetAttribute(&cus, hipDeviceAttributeMultiprocessorCount, dev) != hipSuccess) { grid = -1; return; }
        if (hipFuncSetAttribute((const void*)fwd_megakernel, hipFuncAttributeMaxDynamicSharedMemorySize, LDS_BYTES) != hipSuccess) { fprintf(stderr, "kernel_launch: hipFuncSetAttribute failed\n"); grid = -1; return; }
        if (hipOccupancyMaxActiveBlocksPerMultiprocessor(&per_cu, (const void*)fwd_megakernel, 512, LDS_BYTES) != hipSuccess || per_cu < 1) { fprintf(stderr, "kernel_launch: occupancy query says %d\n", per_cu); per_cu = 1; }
        (void)hipGetLastError();
        grid = cus * per_cu;
        fprintf(stderr, "kernel_launch: grid %d (cus %d x %d), ws %zu\n", grid, cus, per_cu, ws_size);
    }
    if (grid < 0) return;
    Args a{};
    for (int i = 0; i < 14; ++i) a.in[i] = (const float*)d_in[i];
    a.out = (float*)d_out; a.ws = (unsigned char*)d_ws;
#if MK_MULTI
    for (int p = 0; p < NPHASE; ++p) { a.ph_lo = p; a.ph_hi = p + 1; hipLaunchKernelGGL(fwd_megakernel, dim3(grid), dim3(512), LDS_BYTES, stream, a); }
#else
    a.ph_lo = 0; a.ph_hi = NPHASE;
    if (hipMemsetAsync(d_ws, 0, 16384, stream) != hipSuccess) { fprintf(stderr, "kernel_launch: memset failed\n"); return; }
    void* args[] = {&a};
    hipError_t e = hipLaunchCooperativeKernel((const void*)fwd_megakernel, dim3(grid), dim3(512), args, LDS_BYTES, stream);
    if (e != hipSuccess) fprintf(stderr, "kernel_launch: cooperative launch failed: %s (grid %d)\n", hipGetErrorString(e), grid);
#endif
}
```
